# Optimizing an MI355X kernel written in HIP

```python
import jax, jax.numpy as jnp
from jax import lax
import numpy as np

D_MODEL = 1024
BATCH = 8
SEQ = 4096
DEPTH = 2
DEC_BATCH = 2
DEC_SEQ = 16384
PAST_LEN = 128

GRID_W = 64
HEAD_DIM = 64
A_HEADS = 8
NA_KH = 8
NA_KW = 16
B_HEADS = 8
B_KV_HEADS = 2
B_GROUP = B_HEADS // B_KV_HEADS
C_HEADS = 16
C_NOPE = 64
C_ROPE = 32
C_V = 64
C_Q_RANK = 384
C_KV_RANK = 256
ROPE_THETA = 10000.0
Q_BLOCK = 128
EPS = 1e-6
N_EVEN = (DEPTH + 1) // 2
N_ODD = DEPTH // 2

A_WIDTH = A_HEADS * HEAD_DIM
B_WIDTH = B_HEADS * HEAD_DIM
B_KV_WIDTH = B_KV_HEADS * HEAD_DIM
MIX0_WIDTH = A_WIDTH + B_WIDTH
IN0_WIDTH = 3 * A_WIDTH + B_WIDTH + 2 * B_KV_WIDTH + MIX0_WIDTH
C_QK_DIM = C_NOPE + C_ROPE
C_WIDTH = C_HEADS * C_V
IN1_WIDTH = C_Q_RANK + C_KV_RANK + C_ROPE + C_WIDTH

kernel_name = "hybrid_natten_gqa_mla_gated_encoder"


def rms_norm(x, g):
    xf = x.astype(jnp.float32)
    y = xf * lax.rsqrt(jnp.mean(xf * xf, axis=-1, keepdims=True) + EPS)
    return (y * g.astype(jnp.float32)).astype(x.dtype)


def axial_angles(n_tok, rot_dim):
    n_freq = rot_dim // 4
    inv = ROPE_THETA ** (-jnp.arange(n_freq, dtype=jnp.float32) / n_freq)
    t = jnp.arange(n_tok, dtype=jnp.int32)
    row = (t // GRID_W).astype(jnp.float32)
    col = (t % GRID_W).astype(jnp.float32)
    ang = jnp.concatenate([row[:, None] * inv[None], col[:, None] * inv[None]], axis=-1)
    return jnp.cos(ang), jnp.sin(ang)


def apply_rope(x, cos, sin):
    h = x.shape[-1] // 2
    x1 = x[..., :h].astype(jnp.float32)
    x2 = x[..., h:].astype(jnp.float32)
    return jnp.concatenate([x1 * cos - x2 * sin, x1 * sin + x2 * cos], axis=-1).astype(x.dtype)


def heads(t, n_heads, d):
    b, s, _ = t.shape
    return t.reshape(b, s, n_heads, d).transpose(0, 2, 1, 3)


def merge_heads(t):
    b, h, s, d = t.shape
    return t.transpose(0, 2, 1, 3).reshape(b, s, h * d)


def neighbourhood_attention(q, k, v, rpb):
    b, h, s, d = q.shape
    rows = s // GRID_W
    kh = min(NA_KH, rows)
    kw = NA_KW
    qg = q.reshape(b, h, rows, GRID_W, d)
    kg = k.reshape(b, h, rows, GRID_W, d)
    vg = v.reshape(b, h, rows, GRID_W, d)
    col = jnp.arange(GRID_W, dtype=jnp.int32)
    col_start = jnp.clip(col - kw // 2, 0, GRID_W - kw)
    col_idx = col_start[:, None] + jnp.arange(kw, dtype=jnp.int32)[None]
    col_off = col_idx - col[:, None]
    row_start = jnp.clip(jnp.arange(rows, dtype=jnp.int32) - kh // 2, 0, rows - kh)
    scale = d ** -0.5

    def one_row(args):
        r, rs = args
        qr = lax.dynamic_index_in_dim(qg, r, axis=2, keepdims=False)
        kb = lax.dynamic_slice_in_dim(kg, rs, kh, axis=2)
        vb = lax.dynamic_slice_in_dim(vg, rs, kh, axis=2)
        kwin = kb[:, :, :, col_idx]
        vwin = vb[:, :, :, col_idx]
        row_off = rs + jnp.arange(kh, dtype=jnp.int32) - r
        bias = rpb[:, row_off[:, None, None] + NA_KH - 1,
                   col_off[None] + NA_KW - 1]
        sc = jnp.einsum('bhwd,bhrwkd->bhwrk', qr, kwin).astype(jnp.float32) * scale
        sc = sc + bias.transpose(0, 2, 1, 3)[None].astype(jnp.float32)
        p = jax.nn.softmax(sc.reshape(b, h, GRID_W, kh * kw), axis=-1)
        p = p.reshape(b, h, GRID_W, kh, kw).astype(v.dtype)
        return jnp.einsum('bhwrk,bhrwkd->bhwd', p, vwin)

    out = lax.map(one_row, (jnp.arange(rows, dtype=jnp.int32), row_start))
    return out.transpose(1, 2, 0, 3, 4).reshape(b, h, s, d)


def block_attention(q, k, v, scale):
    b, hk, g, s, dk = q.shape
    dv = v.shape[-1]
    nb = s // Q_BLOCK
    qb = q.reshape(b, hk, g, nb, Q_BLOCK, dk).transpose(3, 0, 1, 2, 4, 5)

    def one_block(qi):
        sc = jnp.einsum('bkgqd,bksd->bkgqs', qi, k).astype(jnp.float32) * scale
        p = jax.nn.softmax(sc, axis=-1).astype(v.dtype)
        return jnp.einsum('bkgqs,bksd->bkgqd', p, v)

    out = lax.map(one_block, qb)
    return out.transpose(1, 2, 3, 0, 4, 5).reshape(b, hk, g, s, dv)


def layer_even(x, g_norm, w_in, rpb, qn_g, kn_g, w_out):
    b, s, _ = x.shape
    h = rms_norm(x, g_norm)
    proj = h @ w_in
    o1 = A_WIDTH
    o2 = 2 * A_WIDTH
    o3 = 3 * A_WIDTH
    o4 = o3 + B_WIDTH
    o5 = o4 + B_KV_WIDTH
    o6 = o5 + B_KV_WIDTH
    qa, ka, va, qb, kb, vb, gate = jnp.split(proj, [o1, o2, o3, o4, o5, o6], axis=-1)
    out_a = neighbourhood_attention(heads(qa, A_HEADS, HEAD_DIM), heads(ka, A_HEADS, HEAD_DIM),
                                    heads(va, A_HEADS, HEAD_DIM), rpb)
    cos, sin = axial_angles(s, HEAD_DIM)
    qh = apply_rope(rms_norm(heads(qb, B_HEADS, HEAD_DIM), qn_g), cos, sin)
    kh = apply_rope(rms_norm(heads(kb, B_KV_HEADS, HEAD_DIM), kn_g), cos, sin)
    vh = heads(vb, B_KV_HEADS, HEAD_DIM)
    qh = qh.reshape(b, B_KV_HEADS, B_GROUP, s, HEAD_DIM)
    out_b = block_attention(qh, kh, vh, HEAD_DIM ** -0.5).reshape(b, B_HEADS, s, HEAD_DIM)
    mixed = jnp.concatenate([merge_heads(out_a), merge_heads(out_b)], axis=-1)
    return x + (mixed * jax.nn.silu(gate)) @ w_out


def layer_odd(x, g_norm, w_in, qlat_g, kvlat_g, w_uq, w_ukv, w_out):
    b, s, _ = x.shape
    h = rms_norm(x, g_norm)
    proj = h @ w_in
    cq, ckv, k_rope, gate = jnp.split(
        proj, [C_Q_RANK, C_Q_RANK + C_KV_RANK, C_Q_RANK + C_KV_RANK + C_ROPE], axis=-1)
    q = heads(rms_norm(cq, qlat_g) @ w_uq, C_HEADS, C_QK_DIM)
    kv = heads(rms_norm(ckv, kvlat_g) @ w_ukv, C_HEADS, C_NOPE + C_V)
    q_nope, q_rope = q[..., :C_NOPE], q[..., C_NOPE:]
    k_nope, v = kv[..., :C_NOPE], kv[..., C_NOPE:]
    cos, sin = axial_angles(s, C_ROPE)
    q_rope = apply_rope(q_rope, cos, sin)
    k_r = apply_rope(k_rope[:, None], cos, sin)
    k = jnp.concatenate([k_nope, jnp.broadcast_to(k_r, (b, C_HEADS, s, C_ROPE))], axis=-1)
    qf = jnp.concatenate([q_nope, q_rope], axis=-1)[:, :, None]
    out = block_attention(qf, k, v, C_QK_DIM ** -0.5)[:, :, 0]
    mixed = merge_heads(out)
    return x + (mixed * jax.nn.silu(gate)) @ w_out


def trunk(x, norm_e, w_in_e, rpb_a, qnorm_b, knorm_b, w_out_e,
          norm_o, w_in_o, qlat_g, kvlat_g, w_uq, w_ukv, w_out_o, norm_f):
    for layer in range(DEPTH):
        i = layer // 2
        if layer % 2 == 0:
            x = layer_even(x, norm_e[i], w_in_e[i], rpb_a[i], qnorm_b[i], knorm_b[i], w_out_e[i])
        else:
            x = layer_odd(x, norm_o[i], w_in_o[i], qlat_g[i], kvlat_g[i], w_uq[i], w_ukv[i],
                          w_out_o[i])
    return rms_norm(x, norm_f)


def setup_inputs(seed: int = 0) -> dict:
    key = jax.random.key(seed)
    ks = jax.random.split(key, 18)

    def nrm(k, shape, fan_in):
        return jax.random.normal(k, shape, jnp.float32) * (fan_in ** -0.5)

    def gain(k, shape):
        return 1.0 + 0.01 * jax.random.normal(k, shape, jnp.float32)

    return {
        "x_prompt": jax.random.normal(ks[0], (BATCH, SEQ, D_MODEL), jnp.float32),
        "x_sample": jax.random.normal(ks[1], (DEC_BATCH, DEC_SEQ, D_MODEL), jnp.float32),
        "norm_e": gain(ks[2], (N_EVEN, D_MODEL)),
        "w_in_e": nrm(ks[3], (N_EVEN, D_MODEL, IN0_WIDTH), D_MODEL),
        "rpb_a": 0.1 * jax.random.normal(ks[4], (N_EVEN, A_HEADS, 2 * NA_KH - 1, 2 * NA_KW - 1),
                                         jnp.float32),
        "qnorm_b": gain(ks[5], (N_EVEN, HEAD_DIM)),
        "knorm_b": gain(ks[6], (N_EVEN, HEAD_DIM)),
        "w_out_e": nrm(ks[7], (N_EVEN, MIX0_WIDTH, D_MODEL), MIX0_WIDTH),
        "norm_o": gain(ks[8], (N_ODD, D_MODEL)),
        "w_in_o": nrm(ks[9], (N_ODD, D_MODEL, IN1_WIDTH), D_MODEL),
        "qlat_g": gain(ks[10], (N_ODD, C_Q_RANK)),
        "kvlat_g": gain(ks[11], (N_ODD, C_KV_RANK)),
        "w_uq": nrm(ks[12], (N_ODD, C_Q_RANK, C_HEADS * C_QK_DIM), C_Q_RANK),
        "w_ukv": nrm(ks[13], (N_ODD, C_KV_RANK, C_HEADS * (C_NOPE + C_V)), C_KV_RANK),
        "w_out_o": nrm(ks[14], (N_ODD, C_WIDTH, D_MODEL), C_WIDTH),
        "norm_f": gain(ks[15], (D_MODEL,)),
    }


def reference(x_prompt, x_sample, norm_e, w_in_e, rpb_a, qnorm_b, knorm_b, w_out_e,
              norm_o, w_in_o, qlat_g, kvlat_g, w_uq, w_ukv, w_out_o, norm_f):
    y_prompt = trunk(x_prompt, norm_e, w_in_e, rpb_a, qnorm_b, knorm_b, w_out_e,
                     norm_o, w_in_o, qlat_g, kvlat_g, w_uq, w_ukv, w_out_o, norm_f)
    y_sample = trunk(x_sample, norm_e, w_in_e, rpb_a, qnorm_b, knorm_b, w_out_e,
                     norm_o, w_in_o, qlat_g, kvlat_g, w_uq, w_ukv, w_out_o, norm_f)
    return (y_prompt, y_sample)
```

```cpp
#include <hip/hip_runtime.h>
#include <hip/hip_cooperative_groups.h>
#include <cstdio>
namespace cg = cooperative_groups;

typedef unsigned short bf16_t;
using bf16x8 = __attribute__((ext_vector_type(8))) short;
using f32x16 = __attribute__((ext_vector_type(16))) float;
typedef __bf16 bf2_t __attribute__((ext_vector_type(2)));
typedef float f2_t __attribute__((ext_vector_type(2)));
typedef unsigned u32x4 __attribute__((ext_vector_type(4)));
#define DI __device__ __forceinline__
#define MFMA(a, b, c) __builtin_amdgcn_mfma_f32_32x32x16_bf16((a), (b), (c), 0, 0, 0)

#ifndef PHASE_MASK
#define PHASE_MASK 0xFFFF
#endif
#define PH(n) if ((PHASE_MASK >> (n)) & 1)
static constexpr size_t MiB = 1ull << 20;
static constexpr float LOG2E = 1.4426950408889634f;
static constexpr float LOG2_THETA = 13.287712379549449f;

DI unsigned pk2(float a, float b) { f2_t v = {a, b}; bf2_t o = __builtin_convertvector(v, bf2_t); return __builtin_bit_cast(unsigned, o); }
DI float bflo(unsigned u) { return __uint_as_float(u << 16); }
DI float bfhi(unsigned u) { return __uint_as_float(u & 0xffff0000u); }
DI float fexp2(float x) { return __builtin_amdgcn_exp2f(x); }
DI int crow(int i, int h) { return (i & 3) + 8 * (i >> 2) + 4 * h; }
DI float silu(float x) { return x / (1.f + __expf(-x)); }

struct Params {
  const float* xp; const float* xs;
  const float* norm_e; const float* w_in_e; const float* rpb; const float* qn; const float* kn; const float* w_out_e;
  const float* norm_o; const float* w_in_o; const float* qlat_g; const float* kvlat_g; const float* w_uq; const float* w_ukv;
  const float* w_out_o; const float* norm_f;
  float* out; char* ws;
};

#define WS_WT0   (0 * MiB)
#define WS_WTO0  (7 * MiB)
#define WS_WT1   (9 * MiB)
#define WS_WTUQ  (13 * MiB)
#define WS_WTUKV (15 * MiB)
#define WS_WTO1  (16 * MiB)
#define WS_TAB   (20 * MiB)
#define WS_QA    (32 * MiB)
#define WS_KA    (96 * MiB)
#define WS_VAT   (160 * MiB)
#define WS_QB    (224 * MiB)
#define WS_KB    (288 * MiB)
#define WS_VBT   (304 * MiB)
#define WS_G0    (320 * MiB)
#define WS_LAT   (32 * MiB)
#define WS_G1    (128 * MiB)
#define WS_HB1   (256 * MiB)
#define WS_QC    (256 * MiB)
#define WS_KN    (352 * MiB)
#define WS_VT    (416 * MiB)
#define WS_NEED  (480 * MiB)

DI void seq_of(int t, int& tb, int& S) {
  if (t < 32768) { S = 4096; tb = t & ~4095; } else { S = 16384; tb = 32768 + ((t - 32768) & ~16383); }
}

DI void store4(bf16_t* dst, float a, float b, float c, float d) {
  uint2 v; v.x = pk2(a, b); v.y = pk2(c, d); *(uint2*)dst = v;
}

DI void transpose_tile(const float* __restrict__ W, int N, int k0, int n0, bf16_t* __restrict__ WT, int K, int nrow_out, float* tile) {
  const int tid = threadIdx.x;
  const int nn = tid & 31, kq = (tid >> 5) & 7;
  if (tid < 256) {
#pragma unroll
    for (int j = 0; j < 8; ++j) { int kk = kq + 8 * j; tile[kk * 33 + nn] = W[(size_t)(k0 + kk) * N + n0 + nn]; }
  }
  __syncthreads();
  if (tid < 256) {
    const int nn2 = tid >> 3, kc = tid & 7;
    float v[8];
#pragma unroll
    for (int j = 0; j < 8; ++j) v[j] = tile[(kc * 8 + j) * 33 + nn2];
    uint4 o; o.x = pk2(v[0], v[1]); o.y = pk2(v[2], v[3]); o.z = pk2(v[4], v[5]); o.w = pk2(v[6], v[7]);
    *(uint4*)(WT + (size_t)(nrow_out + nn2) * K + k0 + kc * 8) = o;
  }
  __syncthreads();
}

DI void rmsnorm_row_bf16(const float* __restrict__ src, const float* __restrict__ g, bf16_t* __restrict__ dst, int lane) {
  float4 v[4]; float ss = 0.f;
#pragma unroll
  for (int i = 0; i < 4; ++i) { v[i] = *(const float4*)(src + i * 256 + lane * 4); ss += v[i].x * v[i].x + v[i].y * v[i].y + v[i].z * v[i].z + v[i].w * v[i].w; }
#pragma unroll
  for (int o = 32; o > 0; o >>= 1) ss += __shfl_xor(ss, o);
  const float rs = rsqrtf(ss * (1.f / 1024.f) + 1e-6f);
#pragma unroll
  for (int i = 0; i < 4; ++i) {
    float4 gg = *(const float4*)(g + i * 256 + lane * 4);
    store4(dst + i * 256 + lane * 4, v[i].x * rs * gg.x, v[i].y * rs * gg.y, v[i].z * rs * gg.z, v[i].w * rs * gg.w);
  }
}

DI void rmsnorm_2rows_bf16(const float* __restrict__ s0, const float* __restrict__ s1, const float* __restrict__ g,
                           bf16_t* __restrict__ d0, bf16_t* __restrict__ d1, int lane) {
  float4 a[4], b[4]; float sa = 0.f, sb = 0.f;
#pragma unroll
  for (int i = 0; i < 4; ++i) { a[i] = *(const float4*)(s0 + i * 256 + lane * 4); b[i] = *(const float4*)(s1 + i * 256 + lane * 4); }
#pragma unroll
  for (int i = 0; i < 4; ++i) {
    sa += a[i].x * a[i].x + a[i].y * a[i].y + a[i].z * a[i].z + a[i].w * a[i].w;
    sb += b[i].x * b[i].x + b[i].y * b[i].y + b[i].z * b[i].z + b[i].w * b[i].w;
  }
#pragma unroll
  for (int o = 32; o > 0; o >>= 1) { sa += __shfl_xor(sa, o); sb += __shfl_xor(sb, o); }
  const float ra = rsqrtf(sa * (1.f / 1024.f) + 1e-6f), rb = rsqrtf(sb * (1.f / 1024.f) + 1e-6f);
#pragma unroll
  for (int i = 0; i < 4; ++i) {
    const float4 gg = *(const float4*)(g + i * 256 + lane * 4);
    store4(d0 + i * 256 + lane * 4, a[i].x * ra * gg.x, a[i].y * ra * gg.y, a[i].z * ra * gg.z, a[i].w * ra * gg.w);
    store4(d1 + i * 256 + lane * 4, b[i].x * rb * gg.x, b[i].y * rb * gg.y, b[i].z * rb * gg.z, b[i].w * rb * gg.w);
  }
}
DI void rmsnorm_2rows_f32(float* __restrict__ d0, float* __restrict__ d1, const float* __restrict__ g, int lane) {
  float4 a[4], b[4]; float sa = 0.f, sb = 0.f;
#pragma unroll
  for (int i = 0; i < 4; ++i) { a[i] = *(const float4*)(d0 + i * 256 + lane * 4); b[i] = *(const float4*)(d1 + i * 256 + lane * 4); }
#pragma unroll
  for (int i = 0; i < 4; ++i) {
    sa += a[i].x * a[i].x + a[i].y * a[i].y + a[i].z * a[i].z + a[i].w * a[i].w;
    sb += b[i].x * b[i].x + b[i].y * b[i].y + b[i].z * b[i].z + b[i].w * b[i].w;
  }
#pragma unroll
  for (int o = 32; o > 0; o >>= 1) { sa += __shfl_xor(sa, o); sb += __shfl_xor(sb, o); }
  const float ra = rsqrtf(sa * (1.f / 1024.f) + 1e-6f), rb = rsqrtf(sb * (1.f / 1024.f) + 1e-6f);
#pragma unroll
  for (int i = 0; i < 4; ++i) {
    const float4 gg = *(const float4*)(g + i * 256 + lane * 4);
    float4 o; o.x = a[i].x * ra * gg.x; o.y = a[i].y * ra * gg.y; o.z = a[i].z * ra * gg.z; o.w = a[i].w * ra * gg.w;
    *(float4*)(d0 + i * 256 + lane * 4) = o;
    o.x = b[i].x * rb * gg.x; o.y = b[i].y * rb * gg.y; o.z = b[i].z * rb * gg.z; o.w = b[i].w * rb * gg.w;
    *(float4*)(d1 + i * 256 + lane * 4) = o;
  }
}

using f32x4 = __attribute__((ext_vector_type(4))) float;
DI int g8_lds_byte(int r, int c) {
  int st = (r >> 4) * 2 + (c >> 5), rr = r & 15, cc = c & 31, ob = rr * 64 + cc * 2;
  return st * 1024 + (ob ^ (((ob >> 9) & 1) << 5));
}
DI void g8_stage_rc(int b, int& R, int& C) {
  int st = b / 1024, sb = b % 1024, swz = sb ^ (((sb >> 9) & 1) << 5);
  R = (st >> 1) * 16 + swz / 64; C = (st & 1) * 32 + (swz % 64) / 2;
}
template <class Epi>
DI void gemm_tile(const bf16_t* __restrict__ Bt, int ldb, const bf16_t* __restrict__ A, int K, int bcol, int brow, char* smem, Epi epi) {
  constexpr int BK = 64, HALF = 128, HT = HALF * BK;
  bf16_t* shm = (bf16_t*)smem;
  const int lda = K;
#define G8_SA(b, h) (shm + ((b) * 2 + (h)) * HT)
#define G8_SB(b, h) (shm + (4 + (b) * 2 + (h)) * HT)
#define G8_STAGE(P, BASE, LD, OFF, br, kt) do { const bf16_t* _gp = (BASE) + ((long)(br) * (LD) + (long)(kt) * BK); \
    __builtin_amdgcn_global_load_lds((const unsigned*)(_gp + OFF##0), (__attribute__((address_space(3))) unsigned*)((char*)(P) + tid * 16), 16, 0, 0); \
    __builtin_amdgcn_global_load_lds((const unsigned*)(_gp + OFF##1), (__attribute__((address_space(3))) unsigned*)((char*)(P) + tid * 16 + 8192), 16, 0, 0); } while (0)
#define G8_LDA(dst, b, h) for (int m = 0; m < 4; ++m) for (int k = 0; k < 2; ++k) \
    dst[m][k] = *reinterpret_cast<const bf16x8*>((char*)G8_SA(b, h) + g8_lds_byte(wr * 64 + m * 16 + fr, k * 32 + fq * 8))
#define G8_LDB(dst, b, h) for (int n = 0; n < 2; ++n) for (int k = 0; k < 2; ++k) \
    dst[n][k] = *reinterpret_cast<const bf16x8*>((char*)G8_SB(b, h) + g8_lds_byte(wc * 32 + n * 16 + fr, k * 32 + fq * 8))
#define G8_MMA(ai, bj, At, Bt_) do { __builtin_amdgcn_s_setprio(1); \
    for (int m = 0; m < 4; ++m) for (int n = 0; n < 2; ++n) for (int k = 0; k < 2; ++k) \
      acc[ai][bj][m][n] = __builtin_amdgcn_mfma_f32_16x16x32_bf16(At[m][k], Bt_[n][k], acc[ai][bj][m][n], 0, 0, 0); \
    __builtin_amdgcn_s_setprio(0); } while (0)
#define G8_WAIT_V(n) asm volatile("s_waitcnt vmcnt(" #n ")" ::: "memory")
#define G8_WAIT_L(n) asm volatile("s_waitcnt lgkmcnt(" #n ")" ::: "memory")
#define G8_BAR __builtin_amdgcn_s_barrier()
#define G8_SCHED __builtin_amdgcn_sched_barrier(0)
  int tid = threadIdx.x;
  asm volatile("" : "+v"(tid));
  const int wid = tid >> 6, lane = tid & 63, wr = wid >> 2, wc = wid & 3, fr = lane & 15, fq = lane >> 4;
  unsigned offA0, offA1, offB0, offB1;
  { int r0, c0, r1, c1; g8_stage_rc(tid * 16, r0, c0); g8_stage_rc(tid * 16 + 8192, r1, c1);
    offA0 = r0 * lda + c0; offA1 = r1 * lda + c1; offB0 = r0 * ldb + c0; offB1 = r1 * ldb + c1; }
  f32x4 acc[2][2][4][2];
#pragma unroll
  for (int a = 0; a < 2; ++a)
#pragma unroll
    for (int b = 0; b < 2; ++b)
#pragma unroll
      for (int m = 0; m < 4; ++m)
#pragma unroll
        for (int n = 0; n < 2; ++n) { acc[a][b][m][n][0] = 0.f; acc[a][b][m][n][1] = 0.f; acc[a][b][m][n][2] = 0.f; acc[a][b][m][n][3] = 0.f; }
  bf16x8 At[4][2], B0[2][2], B1[2][2];
  const int nt = K / BK;
  __syncthreads();
  G8_STAGE(G8_SB(0, 0), Bt, ldb, offB, bcol, 0); G8_STAGE(G8_SA(0, 0), A, lda, offA, brow, 0);
  G8_STAGE(G8_SB(0, 1), Bt, ldb, offB, bcol + HALF, 0); G8_STAGE(G8_SA(0, 1), A, lda, offA, brow + HALF, 0);
  if (wr == 1) G8_BAR;
  G8_WAIT_V(4); G8_BAR;
  G8_STAGE(G8_SB(1, 0), Bt, ldb, offB, bcol, 1); G8_STAGE(G8_SA(1, 0), A, lda, offA, brow, 1); G8_STAGE(G8_SB(1, 1), Bt, ldb, offB, bcol + HALF, 1);
  G8_WAIT_V(6); G8_BAR;
  for (int t = 0; t < nt - 2; t += 2) {
    G8_LDB(B0, 0, 0); G8_SCHED; G8_LDA(At, 0, 0); G8_STAGE(G8_SA(1, 1), A, lda, offA, brow + HALF, t + 1);
    G8_WAIT_L(8); G8_BAR; G8_WAIT_L(0); G8_MMA(0, 0, At, B0); G8_BAR; G8_SCHED;
    G8_LDB(B1, 0, 1); G8_STAGE(G8_SB(0, 0), Bt, ldb, offB, bcol, t + 2);
    G8_BAR; G8_WAIT_L(0); G8_MMA(0, 1, At, B1); G8_BAR;
    G8_LDA(At, 0, 1); G8_STAGE(G8_SA(0, 0), A, lda, offA, brow, t + 2);
    G8_BAR; G8_WAIT_L(0); G8_MMA(1, 0, At, B0); G8_BAR; G8_SCHED;
    G8_STAGE(G8_SB(0, 1), Bt, ldb, offB, bcol + HALF, t + 2);
    G8_WAIT_V(6); G8_BAR; G8_MMA(1, 1, At, B1); G8_BAR;
    G8_LDB(B0, 1, 0); G8_SCHED; G8_LDA(At, 1, 0); G8_STAGE(G8_SA(0, 1), A, lda, offA, brow + HALF, t + 2);
    G8_WAIT_L(8); G8_BAR; G8_WAIT_L(0); G8_MMA(0, 0, At, B0); G8_BAR; G8_SCHED;
    G8_LDB(B1, 1, 1); G8_STAGE(G8_SB(1, 0), Bt, ldb, offB, bcol, t + 3);
    G8_BAR; G8_WAIT_L(0); G8_MMA(0, 1, At, B1); G8_BAR;
    G8_LDA(At, 1, 1); G8_STAGE(G8_SA(1, 0), A, lda, offA, brow, t + 3);
    G8_BAR; G8_WAIT_L(0); G8_MMA(1, 0, At, B0); G8_BAR; G8_SCHED;
    G8_STAGE(G8_SB(1, 1), Bt, ldb, offB, bcol + HALF, t + 3);
    G8_WAIT_V(6); G8_BAR; G8_MMA(1, 1, At, B1); G8_BAR;
  }
  { G8_LDB(B0, 0, 0); G8_LDA(At, 0, 0); G8_STAGE(G8_SA(1, 1), A, lda, offA, brow + HALF, nt - 1);
    G8_BAR; G8_WAIT_L(0); G8_MMA(0, 0, At, B0); G8_BAR;
    G8_LDB(B1, 0, 1); G8_BAR; G8_WAIT_L(0); G8_MMA(0, 1, At, B1); G8_BAR;
    G8_LDA(At, 0, 1); G8_WAIT_V(4); G8_BAR; G8_WAIT_L(0); G8_MMA(1, 0, At, B0); G8_MMA(1, 1, At, B1); G8_BAR; }
  { G8_LDB(B0, 1, 0); G8_LDA(At, 1, 0); G8_WAIT_V(2); G8_BAR; G8_WAIT_L(0); G8_MMA(0, 0, At, B0); G8_BAR;
    G8_LDB(B1, 1, 1); G8_WAIT_V(0); G8_BAR; G8_WAIT_L(0); G8_MMA(0, 1, At, B1); G8_BAR;
    G8_LDA(At, 1, 1); G8_BAR; G8_WAIT_L(0); G8_MMA(1, 0, At, B0); G8_MMA(1, 1, At, B1); G8_BAR; }
  if (wr == 0) G8_BAR;
  __syncthreads();
  char* stg = smem + wid * 8704;
#pragma unroll
  for (int ai = 0; ai < 2; ++ai)
#pragma unroll
    for (int bj = 0; bj < 2; ++bj)
      epi(acc[ai][bj], brow + ai * HALF + wr * 64, bcol + bj * HALF + wc * 32, fr, fq, stg);
}

static constexpr int STG_LD = 72;
static constexpr int STG_T = 40;
DI void stg_sync() { __builtin_amdgcn_fence(__ATOMIC_RELEASE, "wavefront"); __builtin_amdgcn_wave_barrier(); __builtin_amdgcn_fence(__ATOMIC_ACQUIRE, "wavefront"); }
DI void stg_rm4(bf16_t* stg, int tl, int ch, const f32x4& v, float sc) { store4(stg + tl * STG_LD + ch, v[0] * sc, v[1] * sc, v[2] * sc, v[3] * sc); }
DI void stg_tr4(bf16_t* stg, int tl, int ch, const f32x4& v) {
#pragma unroll
  for (int j = 0; j < 4; ++j) stg[(ch + j) * STG_T + tl] = (bf16_t)(pk2(v[j], 0.f) & 0xffffu);
}
template <int NCH>
DI void copy_out(const bf16_t* stg, bf16_t* dst, size_t ld, int lane) {
  constexpr int RPI = 64 / NCH;
#pragma unroll
  for (int j = 0; j < 32 / RPI; ++j) {
    const int row = lane / NCH + RPI * j, ch = lane % NCH;
    *(u32x4*)(dst + (size_t)row * ld + ch * 8) = *(const u32x4*)(stg + row * STG_LD + ch * 8);
  }
}
DI void copy_out_t(const bf16_t* stg, bf16_t* dst, size_t ld, int lane) {
#pragma unroll
  for (int j = 0; j < 4; ++j) {
    const int row = (lane >> 2) + 16 * j, ch = lane & 3;
    *(u32x4*)(dst + (size_t)row * ld + ch * 8) = *(const u32x4*)(stg + row * STG_T + ch * 8);
  }
}

struct Epi0 {
  char* ws; const float* qn; const float* kn;
  DI void operator()(f32x4 (&a)[4][2], int cb, int nb, int fr, int fq, char* stgc) const {
    bf16_t* stg = (bf16_t*)stgc;
    const int lane = fr + 16 * fq;
    int tb, S; seq_of(nb, tb, S);
    const int s0 = nb - tb;
    const bool tr = (cb >= 1024 && cb < 1536) || (cb >= 2176 && cb < 2304);
#pragma unroll
    for (int n = 0; n < 2; ++n) {
      const int tl = n * 16 + fr;
      const int s = s0 + tl;
      if (tr) {
#pragma unroll
        for (int m = 0; m < 4; ++m) stg_tr4(stg, tl, m * 16 + fq * 4, a[m][n]);
      } else if (cb < 1024) {
        const float sc = cb < 512 ? 0.125f * LOG2E : 1.f;
#pragma unroll
        for (int m = 0; m < 4; ++m) stg_rm4(stg, tl, m * 16 + fq * 4, a[m][n], sc);
      } else if (cb < 2176) {
        const bool isq = cb < 2048;
        const float* gsrc = isq ? qn : kn;
        float ss = 0.f;
#pragma unroll
        for (int m = 0; m < 4; ++m)
#pragma unroll
          for (int j = 0; j < 4; ++j) ss += a[m][n][j] * a[m][n][j];
        ss += __shfl_xor(ss, 16); ss += __shfl_xor(ss, 32);
        const float rs = rsqrtf(ss * (1.f / 64.f) + 1e-6f);
        const float frow = (float)(s >> 6), fcol = (float)(s & 63);
        const float osc = isq ? 0.125f * LOG2E : 1.f;
#pragma unroll
        for (int m = 0; m < 2; ++m) {
          f32x4 o1, o2;
#pragma unroll
          for (int j = 0; j < 4; ++j) {
            const int d1 = m * 16 + fq * 4 + j;
            const float x1 = a[m][n][j] * rs * gsrc[d1], x2 = a[m + 2][n][j] * rs * gsrc[d1 + 32];
            const float inv = fexp2(-(float)(d1 & 15) * (LOG2_THETA / 16.f));
            const float ang = (m == 0 ? frow : fcol) * inv;
            const float c = __cosf(ang), sn = __sinf(ang);
            o1[j] = (x1 * c - x2 * sn) * osc; o2[j] = (x1 * sn + x2 * c) * osc;
          }
          stg_rm4(stg, tl, m * 16 + fq * 4, o1, 1.f); stg_rm4(stg, tl, 32 + m * 16 + fq * 4, o2, 1.f);
        }
      } else {
#pragma unroll
        for (int m = 0; m < 4; ++m) {
          f32x4 o;
#pragma unroll
          for (int j = 0; j < 4; ++j) o[j] = silu(a[m][n][j]);
          stg_rm4(stg, tl, m * 16 + fq * 4, o, 1.f);
        }
      }
    }
    stg_sync();
    if (cb < 512) copy_out<8>(stg, (bf16_t*)(ws + WS_QA) + (size_t)nb * 512 + cb, 512, lane);
    else if (cb < 1024) copy_out<8>(stg, (bf16_t*)(ws + WS_KA) + (size_t)nb * 512 + (cb - 512), 512, lane);
    else if (cb < 1536) copy_out_t(stg, (bf16_t*)(ws + WS_VAT) + (size_t)tb * 512 + (size_t)(cb - 1024) * S + s0, S, lane);
    else if (cb < 2048) copy_out<8>(stg, (bf16_t*)(ws + WS_QB) + (size_t)nb * 512 + (cb - 1536), 512, lane);
    else if (cb < 2176) copy_out<8>(stg, (bf16_t*)(ws + WS_KB) + (size_t)nb * 128 + (cb - 2048), 128, lane);
    else if (cb < 2304) copy_out_t(stg, (bf16_t*)(ws + WS_VBT) + (size_t)tb * 128 + (size_t)(cb - 2176) * S + s0, S, lane);
    else copy_out<8>(stg, (bf16_t*)(ws + WS_G0) + (size_t)nb * 1024 + (cb - 2304), 1024, lane);
    stg_sync();
  }
};

struct Epi1 {
  char* ws;
  DI void operator()(f32x4 (&a)[4][2], int cb, int nb, int fr, int fq, char* stgc) const {
    bf16_t* stg = (bf16_t*)stgc;
    const int lane = fr + 16 * fq;
    if (cb >= 672 && cb < 768) return;
#pragma unroll
    for (int n = 0; n < 2; ++n) {
      const int tl = n * 16 + fr;
#pragma unroll
      for (int m = 0; m < 4; ++m) {
        if (cb < 768) stg_rm4(stg, tl, m * 16 + fq * 4, a[m][n], 1.f);
        else {
          f32x4 o;
#pragma unroll
          for (int j = 0; j < 4; ++j) o[j] = silu(a[m][n][j]);
          stg_rm4(stg, tl, m * 16 + fq * 4, o, 1.f);
        }
      }
    }
    stg_sync();
    if (cb == 640) copy_out<4>(stg, (bf16_t*)(ws + WS_LAT) + (size_t)nb * 672 + 640, 672, lane);
    else if (cb < 640) copy_out<8>(stg, (bf16_t*)(ws + WS_LAT) + (size_t)nb * 672 + cb, 672, lane);
    else copy_out<8>(stg, (bf16_t*)(ws + WS_G1) + (size_t)nb * 1024 + (cb - 768), 1024, lane);
    stg_sync();
  }
};

struct EpiUQ {
  char* ws; int gb;
  DI void operator()(f32x4 (&a)[4][2], int cb, int nb, int fr, int fq, char* stgc) const {
    bf16_t* stg = (bf16_t*)stgc;
    const int lane = fr + 16 * fq;
    const float osc = 0.10206207261596577f * LOG2E;
    int tb, S; seq_of(nb, tb, S);
#pragma unroll
    for (int n = 0; n < 2; ++n) {
      const int tl = n * 16 + fr;
      const int s = nb - tb + tl;
      const float frow = (float)(s >> 6), fcol = (float)(s & 63);
#pragma unroll
      for (int mp = 0; mp < 2; ++mp) {
        const int c32 = cb + 32 * mp;
        if ((c32 % 96) == 64) {
          f32x4 o1, o2;
#pragma unroll
          for (int j = 0; j < 4; ++j) {
            const int p = fq * 4 + j;
            const float inv = fexp2(-(float)(p & 7) * (LOG2_THETA / 8.f));
            const float ang = (p < 8 ? frow : fcol) * inv;
            const float c = __cosf(ang), sn = __sinf(ang);
            const float x1 = a[2 * mp][n][j], x2 = a[2 * mp + 1][n][j];
            o1[j] = x1 * c - x2 * sn; o2[j] = x1 * sn + x2 * c;
          }
          stg_rm4(stg, tl, 32 * mp + fq * 4, o1, osc); stg_rm4(stg, tl, 32 * mp + 16 + fq * 4, o2, osc);
        } else {
          stg_rm4(stg, tl, 32 * mp + fq * 4, a[2 * mp][n], osc); stg_rm4(stg, tl, 32 * mp + 16 + fq * 4, a[2 * mp + 1][n], osc);
        }
      }
    }
    stg_sync();
    copy_out<8>(stg, (bf16_t*)(ws + WS_QC) + (size_t)(nb - gb) * 1536 + cb, 1536, lane);
    stg_sync();
  }
};

struct EpiUKV {
  char* ws; int gb;
  DI void operator()(f32x4 (&a)[4][2], int cb, int nb, int fr, int fq, char* stgc) const {
    bf16_t* stg = (bf16_t*)stgc;
    const int lane = fr + 16 * fq;
    const int head = cb >> 7;
    int tb, S; seq_of(nb, tb, S);
    const bool isv = (cb & 64) != 0;
#pragma unroll
    for (int n = 0; n < 2; ++n) {
      const int tl = n * 16 + fr;
#pragma unroll
      for (int m = 0; m < 4; ++m) {
        if (!isv) stg_rm4(stg, tl, m * 16 + fq * 4, a[m][n], 1.f);
        else stg_tr4(stg, tl, m * 16 + fq * 4, a[m][n]);
      }
    }
    stg_sync();
    if (!isv) copy_out<8>(stg, (bf16_t*)(ws + WS_KN) + (size_t)(nb - gb) * 1024 + head * 64, 1024, lane);
    else copy_out_t(stg, (bf16_t*)(ws + WS_VT) + (size_t)(tb - gb) * 1024 + (size_t)head * 64 * S + (nb - tb), S, lane);
    stg_sync();
  }
};

struct EpiOut {
  const float* xp; const float* xs; float* out; int layer;
  DI void operator()(f32x4 (&a)[4][2], int cb, int nb, int fr, int fq, char* stgc) const {
    float* stg = (float*)stgc;
    const int lane = fr + 16 * fq;
#pragma unroll
    for (int n = 0; n < 2; ++n) {
      const int tl = n * 16 + fr;
#pragma unroll
      for (int m = 0; m < 4; ++m) *(f32x4*)(stg + tl * 68 + m * 16 + fq * 4) = a[m][n];
    }
    stg_sync();
    const float* res = layer == 0 ? (nb < 32768 ? xp + (size_t)nb * 1024 : xs + (size_t)(nb - 32768) * 1024) : out + (size_t)nb * 1024;
    float* dst = out + (size_t)nb * 1024;
#pragma unroll
    for (int j = 0; j < 8; ++j) {
      const int row = (lane >> 4) + 4 * j, c4 = (lane & 15) * 4;
      float4 v = *(const float4*)(stg + row * 68 + c4);
      const float4 rv = *(const float4*)(res + (size_t)row * 1024 + cb + c4);
      v.x += rv.x; v.y += rv.y; v.z += rv.z; v.w += rv.w;
      *(float4*)(dst + (size_t)row * 1024 + cb + c4) = v;
    }
    stg_sync();
  }
};

template <int MODE>
DI void attn_item(const bf16_t* __restrict__ Q, int ldq, const bf16_t* __restrict__ Kp, int ldk, const bf16_t* __restrict__ Kr,
                  const bf16_t* __restrict__ VT, int S, int tile0, int ntiles, bf16_t* __restrict__ G,
                  const float* __restrict__ rpb_h, int R0, int rows, char* smem) {
  constexpr int DQK = MODE == 2 ? 96 : 64;
  constexpr int NKS = DQK / 16;
  constexpr int KLD = DQK + 8;
  constexpr int NKC = MODE == 2 ? 2 : 1;
  constexpr int STAGE = 64 * 104 * 2 + 64 * 72 * 2;
  int tid = threadIdx.x;
  asm volatile("" : "+v"(tid));
  const int lane = tid & 63, w = tid >> 6, r = lane & 31, h = lane >> 5;
  const int pi_r = (r & 0x13) | ((r & 8) >> 1) | ((r & 4) << 1);

  bf16x8 qf[NKS];
  {
    const bf16_t* qp = Q + (size_t)(32 * w + r) * ldq + 8 * h;
#pragma unroll
    for (int ks = 0; ks < NKS; ++ks) qf[ks] = *(const bf16x8*)(qp + 16 * ks);
  }
  int rw = 0, rs = 0, qc = 0, cs = 0;
  if (MODE == 0) {
    rw = R0 + (w >> 1);
    rs = min(max(rw - 4, 0), rows - 8);
    qc = 32 * (w & 1) + r;
    cs = min(max(qc - 8, 0), 48);
  }
  f32x16 O0, O1;
#pragma unroll
  for (int i = 0; i < 16; ++i) { O0[i] = 0.f; O1[i] = 0.f; }
  float l = 0.f, m = 0.f;
  bool first = true, mzero = true;

  const bf16_t* kp[NKC]; const bf16_t* vp[1];
  int krow[NKC], kcol[NKC]; long kstep[NKC];
#pragma unroll
  for (int i = 0; i < NKC; ++i) {
    const int c = i == 0 ? tid : 512 + (tid & 255);
    if (MODE == 2) {
      const int row = c / 12, kc = c - 12 * row;
      krow[i] = row; kcol[i] = kc * 8;
      kp[i] = kc < 8 ? Kp + (size_t)(tile0 * 64 + row) * ldk + kc * 8 : Kr + (size_t)(tile0 * 64 + row) * 672 + (kc - 8) * 8;
      kstep[i] = kc < 8 ? (long)64 * ldk : (long)64 * 672;
    } else {
      const int row = c >> 3, kc = c & 7;
      krow[i] = row; kcol[i] = kc * 8;
      kp[i] = Kp + (size_t)(tile0 * 64 + row) * ldk + kc * 8;
      kstep[i] = (long)64 * ldk;
    }
  }
  { const int d = tid >> 3, kc = tid & 7; vp[0] = VT + (size_t)d * S + tile0 * 64 + kc * 8; }

  u32x4 kregA[NKC], vregA[1], kregB[NKC], vregB[1];
  auto prefetch = [&](u32x4 (&kreg)[NKC], u32x4 (&vreg)[1], bool adv) {
#pragma unroll
    for (int i = 0; i < NKC; ++i) { kreg[i] = *(const u32x4*)kp[i]; kp[i] += adv ? kstep[i] : 0; }
#pragma unroll
    for (int i = 0; i < 1; ++i) { vreg[i] = *(const u32x4*)vp[i]; vp[i] += adv ? 64 : 0; }
  };
  auto stage_write = [&](char* st, u32x4 (&kreg)[NKC], u32x4 (&vreg)[1]) {
    bf16_t(*wK)[KLD] = (bf16_t(*)[KLD])st;
    bf16_t(*wV)[72] = (bf16_t(*)[72])(st + 64 * 104 * 2);
#pragma unroll
    for (int i = 0; i < NKC; ++i) *(u32x4*)&wK[krow[i]][kcol[i]] = kreg[i];
    { const int d = tid >> 3, kc = tid & 7; *(u32x4*)&wV[d][kc * 8] = vreg[0]; }
  };
  __syncthreads();
  prefetch(kregA, vregA, ntiles > 1);
  prefetch(kregB, vregB, ntiles > 2);
  stage_write(smem, kregA, vregA);
  __syncthreads();
  auto compute = [&](int tile, const char* st) {
    if (MODE != 0 || (tile >= rs && tile < rs + 8)) {
      const bf16_t(*sK)[KLD] = (const bf16_t(*)[KLD])st;
      const bf16_t(*sV)[72] = (const bf16_t(*)[72])(st + 64 * 104 * 2);
      f32x16 s0, s1;
#pragma unroll
      for (int i = 0; i < 16; ++i) { s0[i] = 0.f; s1[i] = 0.f; }
      bf16x8 ka[NKS][2];
#pragma unroll
      for (int ks = 0; ks < NKS; ++ks) {
        ka[ks][0] = *(const bf16x8*)&sK[pi_r][16 * ks + 8 * h];
        ka[ks][1] = *(const bf16x8*)&sK[32 + pi_r][16 * ks + 8 * h];
      }
#pragma unroll
      for (int ks = 0; ks < NKS; ++ks) {
        s0 = MFMA(ka[ks][0], qf[ks], s0);
        s1 = MFMA(ka[ks][1], qf[ks], s1);
      }
      bf16x8 va[4][2];
#pragma unroll
      for (int sp = 0; sp < 4; ++sp) {
        va[sp][0] = *(const bf16x8*)&sV[r][16 * sp + 8 * h];
        va[sp][1] = *(const bf16x8*)&sV[32 + r][16 * sp + 8 * h];
      }
      if (MODE == 0) {
        int mb = 8 * h - cs;
        asm volatile("" : "+v"(mb));
        const float* bp = rpb_h + (tile - rw + 7) * 128 + (8 * h - qc + 63);
#pragma unroll
        for (int i = 0; i < 16; ++i) {
          const int ci = 16 * (i >> 3) + (i & 7);
          const float b0 = bp[ci], b1 = bp[ci + 32];
          s0[i] = ((unsigned)(mb + ci) < 16u) ? s0[i] + b0 : -1e30f;
          s1[i] = ((unsigned)(mb + ci + 32) < 16u) ? s1[i] + b1 : -1e30f;
        }
      }
      bf16x8 pf[4]; float psum;
      auto expsum = [&](float mm) {
        float ps0 = 0.f, ps1 = 0.f;
        u32x4 u0, u1, u2, u3;
#define EP(dst, sv, j) { const float a_ = fexp2(sv[j] - mm), b_ = fexp2(sv[j + 1] - mm); ps0 = (ps0 + a_) + b_; dst = pk2(a_, b_); }
        EP(u0.x, s0, 0) EP(u0.y, s0, 2) EP(u0.z, s0, 4) EP(u0.w, s0, 6)
        EP(u1.x, s0, 8) EP(u1.y, s0, 10) EP(u1.z, s0, 12) EP(u1.w, s0, 14)
        EP(u2.x, s1, 0) EP(u2.y, s1, 2) EP(u2.z, s1, 4) EP(u2.w, s1, 6)
        EP(u3.x, s1, 8) EP(u3.y, s1, 10) EP(u3.z, s1, 12) EP(u3.w, s1, 14)
#undef EP
        pf[0] = __builtin_bit_cast(bf16x8, u0); pf[1] = __builtin_bit_cast(bf16x8, u1);
        pf[2] = __builtin_bit_cast(bf16x8, u2); pf[3] = __builtin_bit_cast(bf16x8, u3);
        psum = ps0 + ps1;
      };
      if (mzero) expsum(0.f); else expsum(m);
      if (__any((psum > 1.15e18f) || (first && psum < 8.7e-19f))) {
        float tmax = fmaxf(s0[0], s1[0]);
#pragma unroll
        for (int i = 1; i < 16; ++i) tmax = fmaxf(tmax, fmaxf(s0[i], s1[i]));
        tmax = fmaxf(tmax, __shfl_xor(tmax, 32));
        const float mn = first ? tmax : fmaxf(m, tmax);
        const float alpha = first ? 1.f : fexp2(m - mn);
        m = mn; mzero = false;
        l *= alpha;
#pragma unroll
        for (int i = 0; i < 16; ++i) { O0[i] *= alpha; O1[i] *= alpha; }
        expsum(m);
      }
      first = false;
      l += psum;
#pragma unroll
      for (int sp = 0; sp < 4; ++sp) {
        O0 = MFMA(va[sp][0], pf[sp], O0);
        O1 = MFMA(va[sp][1], pf[sp], O1);
      }
    }
  };
  for (int tt = 0; tt < ntiles; tt += 2) {
    prefetch(kregA, vregA, tt + 3 < ntiles);
    compute(tile0 + tt, smem);
    stage_write(smem + STAGE, kregB, vregB);
    __syncthreads();
    if (tt + 1 < ntiles) {
      prefetch(kregB, vregB, tt + 4 < ntiles);
      compute(tile0 + tt + 1, smem + STAGE);
      stage_write(smem, kregA, vregA);
      __syncthreads();
    }
  }
  l += __shfl_xor(l, 32);
  const float il = 1.f / l;
  bf16_t* gp = G + (size_t)(32 * w + r) * 1024;
#pragma unroll
  for (int g = 0; g < 4; ++g) {
    {
      bf16_t* p = gp + 8 * g + 4 * h;
      uint2 gv = *(const uint2*)p;
      store4(p, O0[4 * g] * il * bflo(gv.x), O0[4 * g + 1] * il * bfhi(gv.x), O0[4 * g + 2] * il * bflo(gv.y), O0[4 * g + 3] * il * bfhi(gv.y));
    }
    {
      bf16_t* p = gp + 32 + 8 * g + 4 * h;
      uint2 gv = *(const uint2*)p;
      store4(p, O1[4 * g] * il * bflo(gv.x), O1[4 * g + 1] * il * bfhi(gv.x), O1[4 * g + 2] * il * bflo(gv.y), O1[4 * g + 3] * il * bfhi(gv.y));
    }
  }
}

__global__ void __launch_bounds__(512) mega(Params p) {
  cg::grid_group grid = cg::this_grid();
  __shared__ __attribute__((aligned(16))) char smem[147456];
  const int nw = gridDim.x * 8;
#define IDS() int tid = threadIdx.x; asm volatile("" : "+v"(tid)); const int lane = tid & 63, wave = tid >> 6, gw = blockIdx.x * 8 + wave; (void)lane; (void)wave; (void)gw;
  char* ws = p.ws;
  const int vb = (gridDim.x & 7) == 0 ? (int)(blockIdx.x & 7) * (int)(gridDim.x >> 3) + (int)(blockIdx.x >> 3) : (int)blockIdx.x;

  PH(0) {
    IDS()
    for (int it = blockIdx.x; it < 4080; it += gridDim.x) {
      int i = it;
      float* tile = (float*)smem;
      if (i < 1664) { transpose_tile(p.w_in_e, 3328, (i / 104) * 64, (i % 104) * 32, (bf16_t*)(ws + WS_WT0), 1024, (i % 104) * 32, tile); continue; }
      i -= 1664;
      if (i < 512) { transpose_tile(p.w_out_e, 1024, (i / 32) * 64, (i % 32) * 32, (bf16_t*)(ws + WS_WTO0), 1024, (i % 32) * 32, tile); continue; }
      i -= 512;
      if (i < 848) { const int n0 = (i % 53) * 32; transpose_tile(p.w_in_o, 1696, (i / 53) * 64, n0, (bf16_t*)(ws + WS_WT1), 1024, n0 < 672 ? n0 : n0 + 96, tile); continue; }
      i -= 848;
      if (i < 288) { transpose_tile(p.w_uq, 1536, (i / 48) * 64, (i % 48) * 32, (bf16_t*)(ws + WS_WTUQ), 384, (i % 48) * 32, tile); continue; }
      i -= 288;
      if (i < 256) { transpose_tile(p.w_ukv, 2048, (i / 64) * 64, (i % 64) * 32, (bf16_t*)(ws + WS_WTUKV), 256, (i % 64) * 32, tile); continue; }
      i -= 256;
      transpose_tile(p.w_out_o, 1024, (i / 32) * 64, (i % 32) * 32, (bf16_t*)(ws + WS_WTO1), 1024, (i % 32) * 32, tile);
    }
    for (int i = blockIdx.x * 512 + tid; i < 96 * 1024 / 8; i += gridDim.x * 512) {
      uint4 z; z.x = z.y = z.z = z.w = 0u;
      *(uint4*)((bf16_t*)(ws + WS_WT1) + (size_t)672 * 1024 + (size_t)i * 8) = z;
    }
    for (int i = blockIdx.x * 512 + tid; i < 8 * 15 * 128; i += gridDim.x * 512) {
      const int j = i & 127, hd = i >> 7, off = j - 48;
      ((float*)(ws + WS_TAB))[i] = (off >= 0 && off <= 30) ? p.rpb[hd * 31 + off] * LOG2E : 0.f;
    }
    bf16_t* hb0 = (bf16_t*)p.out;
    for (int t = gw; t < 32768; t += nw)
      rmsnorm_2rows_bf16(p.xp + (size_t)t * 1024, p.xs + (size_t)t * 1024, p.norm_e, hb0 + (size_t)t * 1024, hb0 + (size_t)(t + 32768) * 1024, lane);
  }
  grid.sync();

  PH(1) {
    Epi0 epi{ws, p.qn, p.kn};
    for (int tile = vb; tile < 256 * 13; tile += gridDim.x)
      gemm_tile((const bf16_t*)p.out, 1024, (const bf16_t*)(ws + WS_WT0), 1024, (tile / 13) * 256, (tile % 13) * 256, smem, epi);
  }
  grid.sync();

  PH(2) for (int item = vb; item < 4096; item += gridDim.x) {
    if (item < 2048) {
      int seqtb, S, head, qb;
      if (item < 1024) { const int sq = item >> 9; head = (item >> 6) & 7; qb = item & 63; S = 16384; seqtb = 32768 + sq * 16384; }
      else { const int it = item - 1024; const int sq = it >> 7; head = (it >> 4) & 7; qb = it & 15; S = 4096; seqtb = sq * 4096; }
      const int kvh = head >> 2;
      attn_item<1>((const bf16_t*)(ws + WS_QB) + (size_t)(seqtb + qb * 256) * 512 + head * 64, 512,
                   (const bf16_t*)(ws + WS_KB) + (size_t)seqtb * 128 + kvh * 64, 128, nullptr,
                   (const bf16_t*)(ws + WS_VBT) + (size_t)seqtb * 128 + (size_t)kvh * 64 * S, S, 0, S / 64,
                   (bf16_t*)(ws + WS_G0) + (size_t)(seqtb + qb * 256) * 1024 + 512 + head * 64, nullptr, 0, 0, smem);
    } else {
      const int it = item - 2048;
      const int rq = it >> 3, head = it & 7;
      const int q0 = rq * 256;
      int tb, S; seq_of(q0, tb, S);
      const int rows = S >> 6, R0 = (q0 - tb) >> 6;
      const int rsA = min(max(R0 - 4, 0), rows - 8), rsB = min(max(R0 + 3 - 4, 0), rows - 8);
      attn_item<0>((const bf16_t*)(ws + WS_QA) + (size_t)q0 * 512 + head * 64, 512,
                   (const bf16_t*)(ws + WS_KA) + (size_t)tb * 512 + head * 64, 512, nullptr,
                   (const bf16_t*)(ws + WS_VAT) + (size_t)tb * 512 + (size_t)head * 64 * S, S, rsA, rsB + 8 - rsA,
                   (bf16_t*)(ws + WS_G0) + (size_t)q0 * 1024 + head * 64, (const float*)(ws + WS_TAB) + head * 15 * 128, R0, rows, smem);
    }
  }
  grid.sync();

  PH(3) {
    EpiOut epi{p.xp, p.xs, p.out, 0};
    for (int tile = vb; tile < 256 * 4; tile += gridDim.x)
      gemm_tile((const bf16_t*)(ws + WS_G0), 1024, (const bf16_t*)(ws + WS_WTO0), 1024, (tile >> 2) * 256, (tile & 3) * 256, smem, epi);
  }
  grid.sync();

  PH(4) { IDS() for (int t = gw; t < 32768; t += nw)
    rmsnorm_2rows_bf16(p.out + (size_t)t * 1024, p.out + (size_t)(t + 32768) * 1024, p.norm_o, (bf16_t*)(ws + WS_HB1) + (size_t)t * 1024, (bf16_t*)(ws + WS_HB1) + (size_t)(t + 32768) * 1024, lane);
  }
  grid.sync();

  PH(5) {
    Epi1 epi{ws};
    for (int tile = vb; tile < 256 * 7; tile += gridDim.x)
      gemm_tile((const bf16_t*)(ws + WS_HB1), 1024, (const bf16_t*)(ws + WS_WT1), 1024, (tile / 7) * 256, (tile % 7) * 256, smem, epi);
  }
  grid.sync();

  PH(6) { IDS() for (int t = gw; t < 65536; t += nw) {
    bf16_t* row = (bf16_t*)(ws + WS_LAT) + (size_t)t * 672;
    unsigned cq[3], ckv[2];
    float s1 = 0.f, s2 = 0.f;
#pragma unroll
    for (int j = 0; j < 3; ++j) { cq[j] = *(const unsigned*)(row + 2 * lane + 128 * j); const float a = bflo(cq[j]), b = bfhi(cq[j]); s1 += a * a + b * b; }
#pragma unroll
    for (int j = 0; j < 2; ++j) { ckv[j] = *(const unsigned*)(row + 384 + 2 * lane + 128 * j); const float a = bflo(ckv[j]), b = bfhi(ckv[j]); s2 += a * a + b * b; }
#pragma unroll
    for (int o = 32; o > 0; o >>= 1) { s1 += __shfl_xor(s1, o); s2 += __shfl_xor(s2, o); }
    const float r1 = rsqrtf(s1 * (1.f / 384.f) + 1e-6f), r2 = rsqrtf(s2 * (1.f / 256.f) + 1e-6f);
#pragma unroll
    for (int j = 0; j < 3; ++j) { const int c = 2 * lane + 128 * j; *(unsigned*)(row + c) = pk2(bflo(cq[j]) * r1 * p.qlat_g[c], bfhi(cq[j]) * r1 * p.qlat_g[c + 1]); }
#pragma unroll
    for (int j = 0; j < 2; ++j) { const int c = 2 * lane + 128 * j; *(unsigned*)(row + 384 + c) = pk2(bflo(ckv[j]) * r2 * p.kvlat_g[c], bfhi(ckv[j]) * r2 * p.kvlat_g[c + 1]); }
    if (lane < 16) {
      int tb, S; seq_of(t, tb, S);
      const int s = t - tb;
      const float x1 = bflo((unsigned)row[640 + lane]), x2 = bflo((unsigned)row[656 + lane]);
      const float inv = fexp2(-(float)(lane & 7) * (LOG2_THETA / 8.f));
      const float ang = (lane < 8 ? (float)(s >> 6) : (float)(s & 63)) * inv;
      const float c = __cosf(ang), sn = __sinf(ang);
      row[640 + lane] = (bf16_t)(pk2(x1 * c - x2 * sn, 0.f) & 0xffffu);
      row[656 + lane] = (bf16_t)(pk2(x1 * sn + x2 * c, 0.f) & 0xffffu);
    }
  } }
  grid.sync();

#pragma unroll 1
  for (int g = 0; g < 2; ++g) {
    const int gb = g * 32768;
    PH(7) {
      EpiUQ eq{ws, gb};
      EpiUKV ekv{ws, gb};
      for (int tile = vb; tile < 128 * 14; tile += gridDim.x) {
        const int tt = tile / 14, ct = tile % 14;
        if (ct < 6) gemm_tile((const bf16_t*)(ws + WS_LAT), 672, (const bf16_t*)(ws + WS_WTUQ), 384, gb + tt * 256, ct * 256, smem, eq);
        else gemm_tile((const bf16_t*)(ws + WS_LAT) + 384, 672, (const bf16_t*)(ws + WS_WTUKV), 256, gb + tt * 256, (ct - 6) * 256, smem, ekv);
      }
    }
    grid.sync();
    PH(8) for (int item = vb; item < 2048; item += gridDim.x) {
      int seqtb, S, head, qb;
      if (g == 0) { const int sq = item >> 8; head = (item >> 4) & 15; qb = item & 15; S = 4096; seqtb = sq * 4096; }
      else { const int sq = item >> 10; head = (item >> 6) & 15; qb = item & 63; S = 16384; seqtb = 32768 + sq * 16384; }
      attn_item<2>((const bf16_t*)(ws + WS_QC) + (size_t)(seqtb - gb + qb * 256) * 1536 + head * 96, 1536,
                   (const bf16_t*)(ws + WS_KN) + (size_t)(seqtb - gb) * 1024 + head * 64, 1024,
                   (const bf16_t*)(ws + WS_LAT) + (size_t)seqtb * 672 + 640,
                   (const bf16_t*)(ws + WS_VT) + (size_t)(seqtb - gb) * 1024 + (size_t)head * 64 * S, S, 0, S / 64,
                   (bf16_t*)(ws + WS_G1) + (size_t)(seqtb + qb * 256) * 1024 + head * 64, nullptr, 0, 0, smem);
    }
    grid.sync();
  }

  PH(9) {
    EpiOut epi{p.xp, p.xs, p.out, 1};
    for (int tile = vb; tile < 256 * 4; tile += gridDim.x)
      gemm_tile((const bf16_t*)(ws + WS_G1), 1024, (const bf16_t*)(ws + WS_WTO1), 1024, (tile >> 2) * 256, (tile & 3) * 256, smem, epi);
  }
  grid.sync();

  PH(10) { IDS() for (int t = gw; t < 32768; t += nw)
    rmsnorm_2rows_f32(p.out + (size_t)t * 1024, p.out + (size_t)(t + 32768) * 1024, p.norm_f, lane);
  }
}

extern "C" void kernel_launch(void* const* d_in, const int* in_sizes, int n_in,
                              void* d_out, int out_size, void* d_ws, size_t ws_size,
                              hipStream_t stream) {
  static int grid_blocks = 0;
  if (!grid_blocks) {
    int dev = 0, cus = 0, per_cu = 0;
    (void)hipGetDevice(&dev);
    (void)hipDeviceGetAttribute(&cus, hipDeviceAttributeMultiprocessorCount, dev);
    (void)hipOccupancyMaxActiveBlocksPerMultiprocessor(&per_cu, mega, 512, 0);
    per_cu = 1;
    grid_blocks = cus * per_cu;
  }
  if (ws_size < WS_NEED) { fprintf(stderr, "workspace too small: %zu\n", ws_size); return; }
  Params p{};
  p.xp = (const float*)d_in[0]; p.xs = (const float*)d_in[1];
  p.norm_e = (const float*)d_in[2]; p.w_in_e = (const float*)d_in[3]; p.rpb = (const float*)d_in[4];
  p.qn = (const float*)d_in[5]; p.kn = (const float*)d_in[6]; p.w_out_e = (const float*)d_in[7];
  p.norm_o = (const float*)d_in[8]; p.w_in_o = (const float*)d_in[9]; p.qlat_g = (const float*)d_in[10];
  p.kvlat_g = (const float*)d_in[11]; p.w_uq = (const float*)d_in[12]; p.w_ukv = (const float*)d_in[13];
  p.w_out_o = (const float*)d_in[14]; p.norm_f = (const float*)d_in[15];
  p.out = (float*)d_out; p.ws = (char*)d_ws;
  void* args[] = {&p};
  hipError_t e = hipLaunchCooperativeKernel((void*)mega, dim3(grid_blocks), dim3(512), args, 0, stream);
  if (e != hipSuccess) fprintf(stderr, "cooperative launch failed: %s (grid %d)\n", hipGetErrorString(e), grid_blocks);
}
```

```cpp
#include <hip/hip_runtime.h>
#include <hip/hip_cooperative_groups.h>
#include <cstdio>
namespace cg = cooperative_groups;

typedef unsigned short bf16_t;
using bf16x8 = __attribute__((ext_vector_type(8))) short;
using f32x16 = __attribute__((ext_vector_type(16))) float;
typedef __bf16 bf2_t __attribute__((ext_vector_type(2)));
typedef float f2_t __attribute__((ext_vector_type(2)));
typedef unsigned u32x4 __attribute__((ext_vector_type(4)));
#define DI __device__ __forceinline__
#define MFMA(a, b, c) __builtin_amdgcn_mfma_f32_32x32x16_bf16((a), (b), (c), 0, 0, 0)

#ifndef PHASE_MASK
#define PHASE_MASK 0xFFFF
#endif
#define PH(n) if ((PHASE_MASK >> (n)) & 1)
static constexpr size_t MiB = 1ull << 20;
static constexpr float LOG2E = 1.4426950408889634f;
static constexpr float LOG2_THETA = 13.287712379549449f;

DI unsigned pk2(float a, float b) { f2_t v = {a, b}; bf2_t o = __builtin_convertvector(v, bf2_t); return __builtin_bit_cast(unsigned, o); }
DI float bflo(unsigned u) { return __uint_as_float(u << 16); }
DI float bfhi(unsigned u) { return __uint_as_float(u & 0xffff0000u); }
DI float fexp2(float x) { return __builtin_amdgcn_exp2f(x); }
DI int crow(int i, int h) { return (i & 3) + 8 * (i >> 2) + 4 * h; }
DI float silu(float x) { return x / (1.f + __expf(-x)); }

struct Params {
  const float* xp; const float* xs;
  const float* norm_e; const float* w_in_e; const float* rpb; const float* qn; const float* kn; const float* w_out_e;
  const float* norm_o; const float* w_in_o; const float* qlat_g; const float* kvlat_g; const float* w_uq; const float* w_ukv;
  const float* w_out_o; const float* norm_f;
  float* out; char* ws;
};

#define WS_WT0   (0 * MiB)
#define WS_WTO0  (7 * MiB)
#define WS_WT1   (9 * MiB)
#define WS_WTUQ  (13 * MiB)
#define WS_WTUKV (15 * MiB)
#define WS_WTO1  (16 * MiB)
#define WS_TAB   (20 * MiB)
#define WS_QA    (32 * MiB)
#define WS_KA    (96 * MiB)
#define WS_VAT   (160 * MiB)
#define WS_QB    (224 * MiB)
#define WS_KB    (288 * MiB)
#define WS_VBT   (304 * MiB)
#define WS_G0    (320 * MiB)
#define WS_LAT   (32 * MiB)
#define WS_G1    (128 * MiB)
#define WS_HB1   (256 * MiB)
#define WS_QC    (256 * MiB)
#define WS_KN    (352 * MiB)
#define WS_VT    (416 * MiB)
#define WS_NEED  (480 * MiB)

DI void seq_of(int t, int& tb, int& S) {
  if (t < 32768) { S = 4096; tb = t & ~4095; } else { S = 16384; tb = 32768 + ((t - 32768) & ~16383); }
}

DI void store4(bf16_t* dst, float a, float b, float c, float d) {
  uint2 v; v.x = pk2(a, b); v.y = pk2(c, d); *(uint2*)dst = v;
}

DI void transpose_tile(const float* __restrict__ W, int N, int k0, int n0, bf16_t* __restrict__ WT, int K, int nrow_out, float* tile) {
  const int tid = threadIdx.x;
  const int nn = tid & 31, kq = (tid >> 5) & 7;
  if (tid < 256) {
#pragma unroll
    for (int j = 0; j < 8; ++j) { int kk = kq + 8 * j; tile[kk * 33 + nn] = W[(size_t)(k0 + kk) * N + n0 + nn]; }
  }
  __syncthreads();
  if (tid < 256) {
    const int nn2 = tid >> 3, kc = tid & 7;
    float v[8];
#pragma unroll
    for (int j = 0; j < 8; ++j) v[j] = tile[(kc * 8 + j) * 33 + nn2];
    uint4 o; o.x = pk2(v[0], v[1]); o.y = pk2(v[2], v[3]); o.z = pk2(v[4], v[5]); o.w = pk2(v[6], v[7]);
    *(uint4*)(WT + (size_t)(nrow_out + nn2) * K + k0 + kc * 8) = o;
  }
  __syncthreads();
}

DI void rmsnorm_row_bf16(const float* __restrict__ src, const float* __restrict__ g, bf16_t* __restrict__ dst, int lane) {
  float4 v[4]; float ss = 0.f;
#pragma unroll
  for (int i = 0; i < 4; ++i) { v[i] = *(const float4*)(src + i * 256 + lane * 4); ss += v[i].x * v[i].x + v[i].y * v[i].y + v[i].z * v[i].z + v[i].w * v[i].w; }
#pragma unroll
  for (int o = 32; o > 0; o >>= 1) ss += __shfl_xor(ss, o);
  const float rs = rsqrtf(ss * (1.f / 1024.f) + 1e-6f);
#pragma unroll
  for (int i = 0; i < 4; ++i) {
    float4 gg = *(const float4*)(g + i * 256 + lane * 4);
    store4(dst + i * 256 + lane * 4, v[i].x * rs * gg.x, v[i].y * rs * gg.y, v[i].z * rs * gg.z, v[i].w * rs * gg.w);
  }
}

DI void rmsnorm_2rows_bf16(const float* __restrict__ s0, const float* __restrict__ s1, const float* __restrict__ g,
                           bf16_t* __restrict__ d0, bf16_t* __restrict__ d1, int lane) {
  float4 a[4], b[4]; float sa = 0.f, sb = 0.f;
#pragma unroll
  for (int i = 0; i < 4; ++i) { a[i] = *(const float4*)(s0 + i * 256 + lane * 4); b[i] = *(const float4*)(s1 + i * 256 + lane * 4); }
#pragma unroll
  for (int i = 0; i < 4; ++i) {
    sa += a[i].x * a[i].x + a[i].y * a[i].y + a[i].z * a[i].z + a[i].w * a[i].w;
    sb += b[i].x * b[i].x + b[i].y * b[i].y + b[i].z * b[i].z + b[i].w * b[i].w;
  }
#pragma unroll
  for (int o = 32; o > 0; o >>= 1) { sa += __shfl_xor(sa, o); sb += __shfl_xor(sb, o); }
  const float ra = rsqrtf(sa * (1.f / 1024.f) + 1e-6f), rb = rsqrtf(sb * (1.f / 1024.f) + 1e-6f);
#pragma unroll
  for (int i = 0; i < 4; ++i) {
    const float4 gg = *(const float4*)(g + i * 256 + lane * 4);
    store4(d0 + i * 256 + lane * 4, a[i].x * ra * gg.x, a[i].y * ra * gg.y, a[i].z * ra * gg.z, a[i].w * ra * gg.w);
    store4(d1 + i * 256 + lane * 4, b[i].x * rb * gg.x, b[i].y * rb * gg.y, b[i].z * rb * gg.z, b[i].w * rb * gg.w);
  }
}
DI void rmsnorm_2rows_f32(float* __restrict__ d0, float* __restrict__ d1, const float* __restrict__ g, int lane) {
  float4 a[4], b[4]; float sa = 0.f, sb = 0.f;
#pragma unroll
  for (int i = 0; i < 4; ++i) { a[i] = *(const float4*)(d0 + i * 256 + lane * 4); b[i] = *(const float4*)(d1 + i * 256 + lane * 4); }
#pragma unroll
  for (int i = 0; i < 4; ++i) {
    sa += a[i].x * a[i].x + a[i].y * a[i].y + a[i].z * a[i].z + a[i].w * a[i].w;
    sb += b[i].x * b[i].x + b[i].y * b[i].y + b[i].z * b[i].z + b[i].w * b[i].w;
  }
#pragma unroll
  for (int o = 32; o > 0; o >>= 1) { sa += __shfl_xor(sa, o); sb += __shfl_xor(sb, o); }
  const float ra = rsqrtf(sa * (1.f / 1024.f) + 1e-6f), rb = rsqrtf(sb * (1.f / 1024.f) + 1e-6f);
#pragma unroll
  for (int i = 0; i < 4; ++i) {
    const float4 gg = *(const float4*)(g + i * 256 + lane * 4);
    float4 o; o.x = a[i].x * ra * gg.x; o.y = a[i].y * ra * gg.y; o.z = a[i].z * ra * gg.z; o.w = a[i].w * ra * gg.w;
    *(float4*)(d0 + i * 256 + lane * 4) = o;
    o.x = b[i].x * rb * gg.x; o.y = b[i].y * rb * gg.y; o.z = b[i].z * rb * gg.z; o.w = b[i].w * rb * gg.w;
    *(float4*)(d1 + i * 256 + lane * 4) = o;
  }
}

using f32x4 = __attribute__((ext_vector_type(4))) float;
DI int g8_lds_byte(int r, int c) {
  int st = (r >> 4) * 2 + (c >> 5), rr = r & 15, cc = c & 31, ob = rr * 64 + cc * 2;
  return st * 1024 + (ob ^ (((ob >> 9) & 1) << 5));
}
DI void g8_stage_rc(int b, int& R, int& C) {
  int st = b / 1024, sb = b % 1024, swz = sb ^ (((sb >> 9) & 1) << 5);
  R = (st >> 1) * 16 + swz / 64; C = (st & 1) * 32 + (swz % 64) / 2;
}
template <class Epi>
DI void gemm_tile(const bf16_t* __restrict__ Bt, int ldb, const bf16_t* __restrict__ A, int K, int bcol, int brow, char* smem, Epi epi) {
  constexpr int BK = 64, HALF = 128, HT = HALF * BK;
  bf16_t* shm = (bf16_t*)smem;
  const int lda = K;
#define G8_SA(b, h) (shm + ((b) * 2 + (h)) * HT)
#define G8_SB(b, h) (shm + (4 + (b) * 2 + (h)) * HT)
#define G8_STAGE(P, BASE, LD, OFF, br, kt) do { const bf16_t* _gp = (BASE) + ((long)(br) * (LD) + (long)(kt) * BK); \
    __builtin_amdgcn_global_load_lds((const unsigned*)(_gp + OFF##0), (__attribute__((address_space(3))) unsigned*)((char*)(P) + tid * 16), 16, 0, 0); \
    __builtin_amdgcn_global_load_lds((const unsigned*)(_gp + OFF##1), (__attribute__((address_space(3))) unsigned*)((char*)(P) + tid * 16 + 8192), 16, 0, 0); } while (0)
#define G8_LDA(dst, b, h) for (int m = 0; m < 4; ++m) for (int k = 0; k < 2; ++k) \
    dst[m][k] = *reinterpret_cast<const bf16x8*>((char*)G8_SA(b, h) + g8_lds_byte(wr * 64 + m * 16 + fr, k * 32 + fq * 8))
#define G8_LDB(dst, b, h) for (int n = 0; n < 2; ++n) for (int k = 0; k < 2; ++k) \
    dst[n][k] = *reinterpret_cast<const bf16x8*>((char*)G8_SB(b, h) + g8_lds_byte(wc * 32 + n * 16 + fr, k * 32 + fq * 8))
#define G8_MMA(ai, bj, At, Bt_) do { __builtin_amdgcn_s_setprio(1); \
    for (int m = 0; m < 4; ++m) for (int n = 0; n < 2; ++n) for (int k = 0; k < 2; ++k) \
      acc[ai][bj][m][n] = __builtin_amdgcn_mfma_f32_16x16x32_bf16(At[m][k], Bt_[n][k], acc[ai][bj][m][n], 0, 0, 0); \
    __builtin_amdgcn_s_setprio(0); } while (0)
#define G8_WAIT_V(n) asm volatile("s_waitcnt vmcnt(" #n ")" ::: "memory")
#define G8_WAIT_L(n) asm volatile("s_waitcnt lgkmcnt(" #n ")" ::: "memory")
#define G8_BAR __builtin_amdgcn_s_barrier()
#define G8_SCHED __builtin_amdgcn_sched_barrier(0)
  int tid = threadIdx.x;
  asm volatile("" : "+v"(tid));
  const int wid = tid >> 6, lane = tid & 63, wr = wid >> 2, wc = wid & 3, fr = lane & 15, fq = lane >> 4;
  unsigned offA0, offA1, offB0, offB1;
  { int r0, c0, r1, c1; g8_stage_rc(tid * 16, r0, c0); g8_stage_rc(tid * 16 + 8192, r1, c1);
    offA0 = r0 * lda + c0; offA1 = r1 * lda + c1; offB0 = r0 * ldb + c0; offB1 = r1 * ldb + c1; }
  f32x4 acc[2][2][4][2];
#pragma unroll
  for (int a = 0; a < 2; ++a)
#pragma unroll
    for (int b = 0; b < 2; ++b)
#pragma unroll
      for (int m = 0; m < 4; ++m)
#pragma unroll
        for (int n = 0; n < 2; ++n) { acc[a][b][m][n][0] = 0.f; acc[a][b][m][n][1] = 0.f; acc[a][b][m][n][2] = 0.f; acc[a][b][m][n][3] = 0.f; }
  bf16x8 At[4][2], B0[2][2], B1[2][2];
  const int nt = K / BK;
  __syncthreads();
  G8_STAGE(G8_SB(0, 0), Bt, ldb, offB, bcol, 0); G8_STAGE(G8_SA(0, 0), A, lda, offA, brow, 0);
  G8_STAGE(G8_SB(0, 1), Bt, ldb, offB, bcol + HALF, 0); G8_STAGE(G8_SA(0, 1), A, lda, offA, brow + HALF, 0);
  if (wr == 1) G8_BAR;
  G8_WAIT_V(4); G8_BAR;
  G8_STAGE(G8_SB(1, 0), Bt, ldb, offB, bcol, 1); G8_STAGE(G8_SA(1, 0), A, lda, offA, brow, 1); G8_STAGE(G8_SB(1, 1), Bt, ldb, offB, bcol + HALF, 1);
  G8_WAIT_V(6); G8_BAR;
  for (int t = 0; t < nt - 2; t += 2) {
    G8_LDB(B0, 0, 0); G8_SCHED; G8_LDA(At, 0, 0); G8_STAGE(G8_SA(1, 1), A, lda, offA, brow + HALF, t + 1);
    G8_WAIT_L(8); G8_BAR; G8_WAIT_L(0); G8_MMA(0, 0, At, B0); G8_BAR; G8_SCHED;
    G8_LDB(B1, 0, 1); G8_STAGE(G8_SB(0, 0), Bt, ldb, offB, bcol, t + 2);
    G8_BAR; G8_WAIT_L(0); G8_MMA(0, 1, At, B1); G8_BAR;
    G8_LDA(At, 0, 1); G8_STAGE(G8_SA(0, 0), A, lda, offA, brow, t + 2);
    G8_BAR; G8_WAIT_L(0); G8_MMA(1, 0, At, B0); G8_BAR; G8_SCHED;
    G8_STAGE(G8_SB(0, 1), Bt, ldb, offB, bcol + HALF, t + 2);
    G8_WAIT_V(6); G8_BAR; G8_MMA(1, 1, At, B1); G8_BAR;
    G8_LDB(B0, 1, 0); G8_SCHED; G8_LDA(At, 1, 0); G8_STAGE(G8_SA(0, 1), A, lda, offA, brow + HALF, t + 2);
    G8_WAIT_L(8); G8_BAR; G8_WAIT_L(0); G8_MMA(0, 0, At, B0); G8_BAR; G8_SCHED;
    G8_LDB(B1, 1, 1); G8_STAGE(G8_SB(1, 0), Bt, ldb, offB, bcol, t + 3);
    G8_BAR; G8_WAIT_L(0); G8_MMA(0, 1, At, B1); G8_BAR;
    G8_LDA(At, 1, 1); G8_STAGE(G8_SA(1, 0), A, lda, offA, brow, t + 3);
    G8_BAR; G8_WAIT_L(0); G8_MMA(1, 0, At, B0); G8_BAR; G8_SCHED;
    G8_STAGE(G8_SB(1, 1), Bt, ldb, offB, bcol + HALF, t + 3);
    G8_WAIT_V(6); G8_BAR; G8_MMA(1, 1, At, B1); G8_BAR;
  }
  { G8_LDB(B0, 0, 0); G8_LDA(At, 0, 0); G8_STAGE(G8_SA(1, 1), A, lda, offA, brow + HALF, nt - 1);
    G8_BAR; G8_WAIT_L(0); G8_MMA(0, 0, At, B0); G8_BAR;
    G8_LDB(B1, 0, 1); G8_BAR; G8_WAIT_L(0); G8_MMA(0, 1, At, B1); G8_BAR;
    G8_LDA(At, 0, 1); G8_WAIT_V(4); G8_BAR; G8_WAIT_L(0); G8_MMA(1, 0, At, B0); G8_MMA(1, 1, At, B1); G8_BAR; }
  { G8_LDB(B0, 1, 0); G8_LDA(At, 1, 0); G8_WAIT_V(2); G8_BAR; G8_WAIT_L(0); G8_MMA(0, 0, At, B0); G8_BAR;
    G8_LDB(B1, 1, 1); G8_WAIT_V(0); G8_BAR; G8_WAIT_L(0); G8_MMA(0, 1, At, B1); G8_BAR;
    G8_LDA(At, 1, 1); G8_BAR; G8_WAIT_L(0); G8_MMA(1, 0, At, B0); G8_MMA(1, 1, At, B1); G8_BAR; }
  if (wr == 0) G8_BAR;
  __syncthreads();
  char* stg = smem + wid * 8704;
#pragma unroll
  for (int ai = 0; ai < 2; ++ai)
#pragma unroll
    for (int bj = 0; bj < 2; ++bj)
      epi(acc[ai][bj], brow + ai * HALF + wr * 64, bcol + bj * HALF + wc * 32, fr, fq, stg);
}

static constexpr int STG_LD = 72;
static constexpr int STG_T = 40;
DI void stg_sync() { __builtin_amdgcn_fence(__ATOMIC_RELEASE, "wavefront"); __builtin_amdgcn_wave_barrier(); __builtin_amdgcn_fence(__ATOMIC_ACQUIRE, "wavefront"); }
DI void stg_rm4(bf16_t* stg, int tl, int ch, const f32x4& v, float sc) { store4(stg + tl * STG_LD + ch, v[0] * sc, v[1] * sc, v[2] * sc, v[3] * sc); }
DI void stg_tr4(bf16_t* stg, int tl, int ch, const f32x4& v) {
#pragma unroll
  for (int j = 0; j < 4; ++j) stg[(ch + j) * STG_T + tl] = (bf16_t)(pk2(v[j], 0.f) & 0xffffu);
}
template <int NCH>
DI void copy_out(const bf16_t* stg, bf16_t* dst, size_t ld, int lane) {
  constexpr int RPI = 64 / NCH;
#pragma unroll
  for (int j = 0; j < 32 / RPI; ++j) {
    const int row = lane / NCH + RPI * j, ch = lane % NCH;
    *(u32x4*)(dst + (size_t)row * ld + ch * 8) = *(const u32x4*)(stg + row * STG_LD + ch * 8);
  }
}
DI void copy_out_t(const bf16_t* stg, bf16_t* dst, size_t ld, int lane) {
#pragma unroll
  for (int j = 0; j < 4; ++j) {
    const int row = (lane >> 2) + 16 * j, ch = lane & 3;
    *(u32x4*)(dst + (size_t)row * ld + ch * 8) = *(const u32x4*)(stg + row * STG_T + ch * 8);
  }
}

struct Epi0 {
  char* ws; const float* qn; const float* kn;
  DI void operator()(f32x4 (&a)[4][2], int cb, int nb, int fr, int fq, char* stgc) const {
    bf16_t* stg = (bf16_t*)stgc;
    const int lane = fr + 16 * fq;
    int tb, S; seq_of(nb, tb, S);
    const int s0 = nb - tb;
    const bool tr = (cb >= 1024 && cb < 1536) || (cb >= 2176 && cb < 2304);
#pragma unroll
    for (int n = 0; n < 2; ++n) {
      const int tl = n * 16 + fr;
      const int s = s0 + tl;
      if (tr) {
#pragma unroll
        for (int m = 0; m < 4; ++m) stg_tr4(stg, tl, m * 16 + fq * 4, a[m][n]);
      } else if (cb < 1024) {
        const float sc = cb < 512 ? 0.125f * LOG2E : 1.f;
#pragma unroll
        for (int m = 0; m < 4; ++m) stg_rm4(stg, tl, m * 16 + fq * 4, a[m][n], sc);
      } else if (cb < 2176) {
        const bool isq = cb < 2048;
        const float* gsrc = isq ? qn : kn;
        float ss = 0.f;
#pragma unroll
        for (int m = 0; m < 4; ++m)
#pragma unroll
          for (int j = 0; j < 4; ++j) ss += a[m][n][j] * a[m][n][j];
        ss += __shfl_xor(ss, 16); ss += __shfl_xor(ss, 32);
        const float rs = rsqrtf(ss * (1.f / 64.f) + 1e-6f);
        const float frow = (float)(s >> 6), fcol = (float)(s & 63);
        const float osc = isq ? 0.125f * LOG2E : 1.f;
#pragma unroll
        for (int m = 0; m < 2; ++m) {
          f32x4 o1, o2;
#pragma unroll
          for (int j = 0; j < 4; ++j) {
            const int d1 = m * 16 + fq * 4 + j;
            const float x1 = a[m][n][j] * rs * gsrc[d1], x2 = a[m + 2][n][j] * rs * gsrc[d1 + 32];
            const float inv = fexp2(-(float)(d1 & 15) * (LOG2_THETA / 16.f));
            const float ang = (m == 0 ? frow : fcol) * inv;
            const float c = __cosf(ang), sn = __sinf(ang);
            o1[j] = (x1 * c - x2 * sn) * osc; o2[j] = (x1 * sn + x2 * c) * osc;
          }
          stg_rm4(stg, tl, m * 16 + fq * 4, o1, 1.f); stg_rm4(stg, tl, 32 + m * 16 + fq * 4, o2, 1.f);
        }
      } else {
#pragma unroll
        for (int m = 0; m < 4; ++m) {
          f32x4 o;
#pragma unroll
          for (int j = 0; j < 4; ++j) o[j] = silu(a[m][n][j]);
          stg_rm4(stg, tl, m * 16 + fq * 4, o, 1.f);
        }
      }
    }
    stg_sync();
    if (cb < 512) copy_out<8>(stg, (bf16_t*)(ws + WS_QA) + (size_t)nb * 512 + cb, 512, lane);
    else if (cb < 1024) copy_out<8>(stg, (bf16_t*)(ws + WS_KA) + (size_t)nb * 512 + (cb - 512), 512, lane);
    else if (cb < 1536) copy_out_t(stg, (bf16_t*)(ws + WS_VAT) + (size_t)tb * 512 + (size_t)(cb - 1024) * S + s0, S, lane);
    else if (cb < 2048) copy_out<8>(stg, (bf16_t*)(ws + WS_QB) + (size_t)nb * 512 + (cb - 1536), 512, lane);
    else if (cb < 2176) copy_out<8>(stg, (bf16_t*)(ws + WS_KB) + (size_t)nb * 128 + (cb - 2048), 128, lane);
    else if (cb < 2304) copy_out_t(stg, (bf16_t*)(ws + WS_VBT) + (size_t)tb * 128 + (size_t)(cb - 2176) * S + s0, S, lane);
    else copy_out<8>(stg, (bf16_t*)(ws + WS_G0) + (size_t)nb * 1024 + (cb - 2304), 1024, lane);
    stg_sync();
  }
};

struct Epi1 {
  char* ws;
  DI void operator()(f32x4 (&a)[4][2], int cb, int nb, int fr, int fq, char* stgc) const {
    bf16_t* stg = (bf16_t*)stgc;
    const int lane = fr + 16 * fq;
    if (cb >= 672 && cb < 768) return;
#pragma unroll
    for (int n = 0; n < 2; ++n) {
      const int tl = n * 16 + fr;
#pragma unroll
      for (int m = 0; m < 4; ++m) {
        if (cb < 768) stg_rm4(stg, tl, m * 16 + fq * 4, a[m][n], 1.f);
        else {
          f32x4 o;
#pragma unroll
          for (int j = 0; j < 4; ++j) o[j] = silu(a[m][n][j]);
          stg_rm4(stg, tl, m * 16 + fq * 4, o, 1.f);
        }
      }
    }
    stg_sync();
    if (cb == 640) copy_out<4>(stg, (bf16_t*)(ws + WS_LAT) + (size_t)nb * 672 + 640, 672, lane);
    else if (cb < 640) copy_out<8>(stg, (bf16_t*)(ws + WS_LAT) + (size_t)nb * 672 + cb, 672, lane);
    else copy_out<8>(stg, (bf16_t*)(ws + WS_G1) + (size_t)nb * 1024 + (cb - 768), 1024, lane);
    stg_sync();
  }
};

struct EpiUQ {
  char* ws; int gb;
  DI void operator()(f32x4 (&a)[4][2], int cb, int nb, int fr, int fq, char* stgc) const {
    bf16_t* stg = (bf16_t*)stgc;
    const int lane = fr + 16 * fq;
    const float osc = 0.10206207261596577f * LOG2E;
    int tb, S; seq_of(nb, tb, S);
#pragma unroll
    for (int n = 0; n < 2; ++n) {
      const int tl = n * 16 + fr;
      const int s = nb - tb + tl;
      const float frow = (float)(s >> 6), fcol = (float)(s & 63);
#pragma unroll
      for (int mp = 0; mp < 2; ++mp) {
        const int c32 = cb + 32 * mp;
        if ((c32 % 96) == 64) {
          f32x4 o1, o2;
#pragma unroll
          for (int j = 0; j < 4; ++j) {
            const int p = fq * 4 + j;
            const float inv = fexp2(-(float)(p & 7) * (LOG2_THETA / 8.f));
            const float ang = (p < 8 ? frow : fcol) * inv;
            const float c = __cosf(ang), sn = __sinf(ang);
            const float x1 = a[2 * mp][n][j], x2 = a[2 * mp + 1][n][j];
            o1[j] = x1 * c - x2 * sn; o2[j] = x1 * sn + x2 * c;
          }
          stg_rm4(stg, tl, 32 * mp + fq * 4, o1, osc); stg_rm4(stg, tl, 32 * mp + 16 + fq * 4, o2, osc);
        } else {
          stg_rm4(stg, tl, 32 * mp + fq * 4, a[2 * mp][n], osc); stg_rm4(stg, tl, 32 * mp + 16 + fq * 4, a[2 * mp + 1][n], osc);
        }
      }
    }
    stg_sync();
    copy_out<8>(stg, (bf16_t*)(ws + WS_QC) + (size_t)(nb - gb) * 1536 + cb, 1536, lane);
    stg_sync();
  }
};

struct EpiUKV {
  char* ws; int gb;
  DI void operator()(f32x4 (&a)[4][2], int cb, int nb, int fr, int fq, char* stgc) const {
    bf16_t* stg = (bf16_t*)stgc;
    const int lane = fr + 16 * fq;
    const int head = cb >> 7;
    int tb, S; seq_of(nb, tb, S);
    const bool isv = (cb & 64) != 0;
#pragma unroll
    for (int n = 0; n < 2; ++n) {
      const int tl = n * 16 + fr;
#pragma unroll
      for (int m = 0; m < 4; ++m) {
        if (!isv) stg_rm4(stg, tl, m * 16 + fq * 4, a[m][n], 1.f);
        else stg_tr4(stg, tl, m * 16 + fq * 4, a[m][n]);
      }
    }
    stg_sync();
    if (!isv) copy_out<8>(stg, (bf16_t*)(ws + WS_KN) + (size_t)(nb - gb) * 1024 + head * 64, 1024, lane);
    else copy_out_t(stg, (bf16_t*)(ws + WS_VT) + (size_t)(tb - gb) * 1024 + (size_t)head * 64 * S + (nb - tb), S, lane);
    stg_sync();
  }
};

struct EpiOut {
  const float* xp; const float* xs; float* out; int layer;
  DI void operator()(f32x4 (&a)[4][2], int cb, int nb, int fr, int fq, char* stgc) const {
    float* stg = (float*)stgc;
    const int lane = fr + 16 * fq;
#pragma unroll
    for (int n = 0; n < 2; ++n) {
      const int tl = n * 16 + fr;
#pragma unroll
      for (int m = 0; m < 4; ++m) *(f32x4*)(stg + tl * 68 + m * 16 + fq * 4) = a[m][n];
    }
    stg_sync();
    const float* res = layer == 0 ? (nb < 32768 ? xp + (size_t)nb * 1024 : xs + (size_t)(nb - 32768) * 1024) : out + (size_t)nb * 1024;
    float* dst = out + (size_t)nb * 1024;
#pragma unroll
    for (int j = 0; j < 8; ++j) {
      const int row = (lane >> 4) + 4 * j, c4 = (lane & 15) * 4;
      float4 v = *(const float4*)(stg + row * 68 + c4);
      const float4 rv = *(const float4*)(res + (size_t)row * 1024 + cb + c4);
      v.x += rv.x; v.y += rv.y; v.z += rv.z; v.w += rv.w;
      *(float4*)(dst + (size_t)row * 1024 + cb + c4) = v;
    }
    stg_sync();
  }
};

#define MFMA16(a, b, c) __builtin_amdgcn_mfma_f32_16x16x32_bf16((a), (b), (c), 0, 0, 0)
template <int MODE>
DI void attn_item(const bf16_t* __restrict__ Q, int ldq, const bf16_t* __restrict__ Kp, int ldk, const bf16_t* __restrict__ Kr,
                  const bf16_t* __restrict__ VT, int S, int tile0, int ntiles, bf16_t* __restrict__ G,
                  const float* __restrict__ rpb_h, int R0, int rows, char* smem) {
  constexpr int DQK = MODE == 2 ? 96 : 64;
  constexpr int NK2 = DQK / 32;
  constexpr int KLD = MODE == 2 ? 112 : 80;
  constexpr int VLD = 80;
  constexpr int NKC = MODE == 2 ? 2 : 1;
  constexpr int KBYTES = 64 * 112 * 2;
  constexpr int STAGE = KBYTES + 64 * VLD * 2;
  int tid = threadIdx.x;
  asm volatile("" : "+v"(tid));
  const int lane = tid & 63, w = tid >> 6, i16 = lane & 15, quad = lane >> 4;

  bf16x8 qf[2][NK2];
#pragma unroll
  for (int qb = 0; qb < 2; ++qb)
#pragma unroll
    for (int ks = 0; ks < NK2; ++ks) qf[qb][ks] = *(const bf16x8*)(Q + (size_t)(32 * w + 16 * qb + i16) * ldq + 32 * ks + 8 * quad);
  int rw = 0, rs = 0, qc0 = 0, cs0 = 0, cs1 = 0;
  if (MODE == 0) {
    rw = R0 + (w >> 1);
    rs = min(max(rw - 4, 0), rows - 8);
    qc0 = 32 * (w & 1) + i16;
    cs0 = min(max(qc0 - 8, 0), 48);
    cs1 = min(max(qc0 + 16 - 8, 0), 48);
  }
  f32x4 O[4][2];
#pragma unroll
  for (int db = 0; db < 4; ++db)
#pragma unroll
    for (int qb = 0; qb < 2; ++qb) { O[db][qb][0] = 0.f; O[db][qb][1] = 0.f; O[db][qb][2] = 0.f; O[db][qb][3] = 0.f; }
  float l0 = 0.f, l1 = 0.f, m0 = 0.f, m1 = 0.f;
  bool first = true, mzero = true;

  const bf16_t* kp[NKC]; const bf16_t* vp;
  int krow[NKC], kcol[NKC]; long kstep[NKC];
#pragma unroll
  for (int i = 0; i < NKC; ++i) {
    const int c = i == 0 ? tid : 512 + (tid & 255);
    if (MODE == 2) {
      const int row = c / 12, kc = c - 12 * row;
      krow[i] = row; kcol[i] = kc * 8;
      kp[i] = kc < 8 ? Kp + (size_t)(tile0 * 64 + row) * ldk + kc * 8 : Kr + (size_t)(tile0 * 64 + row) * 672 + (kc - 8) * 8;
      kstep[i] = kc < 8 ? (long)64 * ldk : (long)64 * 672;
    } else {
      const int row = c >> 3, kc = c & 7;
      krow[i] = row; kcol[i] = kc * 8;
      kp[i] = Kp + (size_t)(tile0 * 64 + row) * ldk + kc * 8;
      kstep[i] = (long)64 * ldk;
    }
  }
  const int vd = tid >> 3, vkc = tid & 7;
  vp = VT + (size_t)vd * S + tile0 * 64 + vkc * 8;
  const int vc4 = vkc & 3;
  const int vcol = 32 * (vkc >> 2) + (vc4 < 2 ? 16 * vc4 : 16 * (vc4 - 2) + 4);

  u32x4 kregA[NKC], vregA[1], kregB[NKC], vregB[1];
  auto prefetch = [&](u32x4 (&kreg)[NKC], u32x4 (&vreg)[1], bool adv) {
#pragma unroll
    for (int i = 0; i < NKC; ++i) { kreg[i] = *(const u32x4*)kp[i]; kp[i] += adv ? kstep[i] : 0; }
    vreg[0] = *(const u32x4*)vp; vp += adv ? 64 : 0;
  };
  auto stage_write = [&](char* st, u32x4 (&kreg)[NKC], u32x4 (&vreg)[1]) {
    bf16_t(*wK)[KLD] = (bf16_t(*)[KLD])st;
    bf16_t(*wV)[VLD] = (bf16_t(*)[VLD])(st + KBYTES);
#pragma unroll
    for (int i = 0; i < NKC; ++i) *(u32x4*)&wK[krow[i]][kcol[i]] = kreg[i];
    uint2 lo; lo.x = vreg[0].x; lo.y = vreg[0].y;
    uint2 hi; hi.x = vreg[0].z; hi.y = vreg[0].w;
    *(uint2*)&wV[vd][vcol] = lo;
    *(uint2*)&wV[vd][vcol + 8] = hi;
  };
  __syncthreads();
  prefetch(kregA, vregA, ntiles > 1);
  stage_write(smem, kregA, vregA);
  prefetch(kregB, vregB, ntiles > 2);
  __syncthreads();
  auto compute = [&](int tile, const char* st) {
    if (MODE != 0 || (tile >= rs && tile < rs + 8)) {
      const bf16_t(*sK)[KLD] = (const bf16_t(*)[KLD])st;
      const bf16_t(*sV)[VLD] = (const bf16_t(*)[VLD])(st + KBYTES);
      f32x4 s[4][2];
#pragma unroll
      for (int kb = 0; kb < 4; ++kb)
#pragma unroll
        for (int qb = 0; qb < 2; ++qb) { s[kb][qb][0] = 0.f; s[kb][qb][1] = 0.f; s[kb][qb][2] = 0.f; s[kb][qb][3] = 0.f; }
#pragma unroll
      for (int ks = 0; ks < NK2; ++ks)
#pragma unroll
        for (int kb = 0; kb < 4; ++kb) {
          const bf16x8 a = *(const bf16x8*)&sK[16 * kb + i16][32 * ks + 8 * quad];
          s[kb][0] = MFMA16(a, qf[0][ks], s[kb][0]);
          s[kb][1] = MFMA16(a, qf[1][ks], s[kb][1]);
        }
      bf16x8 va[2][4];
#pragma unroll
      for (int s2 = 0; s2 < 2; ++s2)
#pragma unroll
        for (int db = 0; db < 4; ++db) va[s2][db] = *(const bf16x8*)&sV[16 * db + i16][32 * s2 + 8 * quad];
      if (MODE == 0) {
        int mb0 = 4 * quad - cs0, mb1 = 4 * quad - cs1;
        asm volatile("" : "+v"(mb0), "+v"(mb1));
        const float* bp0 = rpb_h + (tile - rw + 7) * 128 + (4 * quad - qc0 + 63);
        const float* bp1 = bp0 - 16;
#pragma unroll
        for (int kb = 0; kb < 4; ++kb)
#pragma unroll
          for (int j = 0; j < 4; ++j) {
            const int ci = 16 * kb + j;
            const float b0 = bp0[ci], b1 = bp1[ci];
            s[kb][0][j] = ((unsigned)(mb0 + ci) < 16u) ? s[kb][0][j] + b0 : -1e30f;
            s[kb][1][j] = ((unsigned)(mb1 + ci) < 16u) ? s[kb][1][j] + b1 : -1e30f;
          }
      }
      bf16x8 pf[2][2]; float ps0, ps1;
      auto expsum = [&](float mm0, float mm1) {
        float a0 = 0.f, a1 = 0.f;
        u32x4 u00, u01, u10, u11;
#define EPQ(dlo, dhi, kb, qb, mm, acc_) { const float e0 = fexp2(s[kb][qb][0] - mm), e1 = fexp2(s[kb][qb][1] - mm), e2 = fexp2(s[kb][qb][2] - mm), e3 = fexp2(s[kb][qb][3] - mm); \
          acc_ = (((acc_ + e0) + e1) + e2) + e3; dlo = pk2(e0, e1); dhi = pk2(e2, e3); }
        EPQ(u00.x, u00.y, 0, 0, mm0, a0) EPQ(u00.z, u00.w, 1, 0, mm0, a0) EPQ(u10.x, u10.y, 2, 0, mm0, a0) EPQ(u10.z, u10.w, 3, 0, mm0, a0)
        EPQ(u01.x, u01.y, 0, 1, mm1, a1) EPQ(u01.z, u01.w, 1, 1, mm1, a1) EPQ(u11.x, u11.y, 2, 1, mm1, a1) EPQ(u11.z, u11.w, 3, 1, mm1, a1)
#undef EPQ
        pf[0][0] = __builtin_bit_cast(bf16x8, u00); pf[0][1] = __builtin_bit_cast(bf16x8, u01);
        pf[1][0] = __builtin_bit_cast(bf16x8, u10); pf[1][1] = __builtin_bit_cast(bf16x8, u11);
        ps0 = a0; ps1 = a1;
      };
      if (mzero) expsum(0.f, 0.f); else expsum(m0, m1);
      if (__any((ps0 > 1.15e18f) || (ps1 > 1.15e18f) || (first && (ps0 < 8.7e-19f || ps1 < 8.7e-19f)))) {
        float t0 = s[0][0][0], t1 = s[0][1][0];
#pragma unroll
        for (int kb = 0; kb < 4; ++kb)
#pragma unroll
          for (int j = 0; j < 4; ++j) { t0 = fmaxf(t0, s[kb][0][j]); t1 = fmaxf(t1, s[kb][1][j]); }
        t0 = fmaxf(t0, __shfl_xor(t0, 16)); t0 = fmaxf(t0, __shfl_xor(t0, 32));
        t1 = fmaxf(t1, __shfl_xor(t1, 16)); t1 = fmaxf(t1, __shfl_xor(t1, 32));
        const float n0 = first ? t0 : fmaxf(m0, t0), n1 = first ? t1 : fmaxf(m1, t1);
        const float al0 = first ? 1.f : fexp2(m0 - n0), al1 = first ? 1.f : fexp2(m1 - n1);
        m0 = n0; m1 = n1; mzero = false;
        l0 *= al0; l1 *= al1;
#pragma unroll
        for (int db = 0; db < 4; ++db)
#pragma unroll
          for (int j = 0; j < 4; ++j) { O[db][0][j] *= al0; O[db][1][j] *= al1; }
        expsum(m0, m1);
      }
      first = false;
      l0 += ps0; l1 += ps1;
#pragma unroll
      for (int s2 = 0; s2 < 2; ++s2)
#pragma unroll
        for (int db = 0; db < 4; ++db) {
          O[db][0] = MFMA16(va[s2][db], pf[s2][0], O[db][0]);
          O[db][1] = MFMA16(va[s2][db], pf[s2][1], O[db][1]);
        }
    }
  };
  for (int tt = 0; tt < ntiles; tt += 2) {
    prefetch(kregA, vregA, tt + 3 < ntiles);
    compute(tile0 + tt, smem);
    stage_write(smem + STAGE, kregB, vregB);
    __syncthreads();
    if (tt + 1 < ntiles) {
      prefetch(kregB, vregB, tt + 4 < ntiles);
      compute(tile0 + tt + 1, smem + STAGE);
      stage_write(smem, kregA, vregA);
      __syncthreads();
    }
  }
  l0 += __shfl_xor(l0, 16); l0 += __shfl_xor(l0, 32);
  l1 += __shfl_xor(l1, 16); l1 += __shfl_xor(l1, 32);
  const float il0 = 1.f / l0, il1 = 1.f / l1;
#pragma unroll
  for (int qb = 0; qb < 2; ++qb) {
    const float il = qb == 0 ? il0 : il1;
    bf16_t* gp = G + (size_t)(32 * w + 16 * qb + i16) * 1024 + 4 * quad;
#pragma unroll
    for (int db = 0; db < 4; ++db) {
      bf16_t* p = gp + 16 * db;
      const uint2 gv = *(const uint2*)p;
      store4(p, O[db][qb][0] * il * bflo(gv.x), O[db][qb][1] * il * bfhi(gv.x), O[db][qb][2] * il * bflo(gv.y), O[db][qb][3] * il * bfhi(gv.y));
    }
  }
}

__global__ void __launch_bounds__(512) mega(Params p) {
  cg::grid_group grid = cg::this_grid();
  __shared__ __attribute__((aligned(16))) char smem[147456];
  const int nw = gridDim.x * 8;
#define IDS() int tid = threadIdx.x; asm volatile("" : "+v"(tid)); const int lane = tid & 63, wave = tid >> 6, gw = blockIdx.x * 8 + wave; (void)lane; (void)wave; (void)gw;
  char* ws = p.ws;
  const int vb = (gridDim.x & 7) == 0 ? (int)(blockIdx.x & 7) * (int)(gridDim.x >> 3) + (int)(blockIdx.x >> 3) : (int)blockIdx.x;

  PH(0) {
    IDS()
    for (int it = blockIdx.x; it < 4080; it += gridDim.x) {
      int i = it;
      float* tile = (float*)smem;
      if (i < 1664) { transpose_tile(p.w_in_e, 3328, (i / 104) * 64, (i % 104) * 32, (bf16_t*)(ws + WS_WT0), 1024, (i % 104) * 32, tile); continue; }
      i -= 1664;
      if (i < 512) { transpose_tile(p.w_out_e, 1024, (i / 32) * 64, (i % 32) * 32, (bf16_t*)(ws + WS_WTO0), 1024, (i % 32) * 32, tile); continue; }
      i -= 512;
      if (i < 848) { const int n0 = (i % 53) * 32; transpose_tile(p.w_in_o, 1696, (i / 53) * 64, n0, (bf16_t*)(ws + WS_WT1), 1024, n0 < 672 ? n0 : n0 + 96, tile); continue; }
      i -= 848;
      if (i < 288) { transpose_tile(p.w_uq, 1536, (i / 48) * 64, (i % 48) * 32, (bf16_t*)(ws + WS_WTUQ), 384, (i % 48) * 32, tile); continue; }
      i -= 288;
      if (i < 256) { transpose_tile(p.w_ukv, 2048, (i / 64) * 64, (i % 64) * 32, (bf16_t*)(ws + WS_WTUKV), 256, (i % 64) * 32, tile); continue; }
      i -= 256;
      transpose_tile(p.w_out_o, 1024, (i / 32) * 64, (i % 32) * 32, (bf16_t*)(ws + WS_WTO1), 1024, (i % 32) * 32, tile);
    }
    for (int i = blockIdx.x * 512 + tid; i < 96 * 1024 / 8; i += gridDim.x * 512) {
      uint4 z; z.x = z.y = z.z = z.w = 0u;
      *(uint4*)((bf16_t*)(ws + WS_WT1) + (size_t)672 * 1024 + (size_t)i * 8) = z;
    }
    for (int i = blockIdx.x * 512 + tid; i < 8 * 15 * 128; i += gridDim.x * 512) {
      const int j = i & 127, hd = i >> 7, off = j - 48;
      ((float*)(ws + WS_TAB))[i] = (off >= 0 && off <= 30) ? p.rpb[hd * 31 + off] * LOG2E : 0.f;
    }
    bf16_t* hb0 = (bf16_t*)p.out;
    for (int t = gw; t < 32768; t += nw)
      rmsnorm_2rows_bf16(p.xp + (size_t)t * 1024, p.xs + (size_t)t * 1024, p.norm_e, hb0 + (size_t)t * 1024, hb0 + (size_t)(t + 32768) * 1024, lane);
  }
  grid.sync();

  PH(1) {
    Epi0 epi{ws, p.qn, p.kn};
    for (int tile = vb; tile < 256 * 13; tile += gridDim.x)
      gemm_tile((const bf16_t*)p.out, 1024, (const bf16_t*)(ws + WS_WT0), 1024, (tile / 13) * 256, (tile % 13) * 256, smem, epi);
  }
  grid.sync();

  PH(2) for (int item = vb; item < 4096; item += gridDim.x) {
    if (item < 2048) {
      int seqtb, S, head, qb;
      if (item < 1024) { const int sq = item >> 9; head = (item >> 6) & 7; qb = item & 63; S = 16384; seqtb = 32768 + sq * 16384; }
      else { const int it = item - 1024; const int sq = it >> 7; head = (it >> 4) & 7; qb = it & 15; S = 4096; seqtb = sq * 4096; }
      const int kvh = head >> 2;
      attn_item<1>((const bf16_t*)(ws + WS_QB) + (size_t)(seqtb + qb * 256) * 512 + head * 64, 512,
                   (const bf16_t*)(ws + WS_KB) + (size_t)seqtb * 128 + kvh * 64, 128, nullptr,
                   (const bf16_t*)(ws + WS_VBT) + (size_t)seqtb * 128 + (size_t)kvh * 64 * S, S, 0, S / 64,
                   (bf16_t*)(ws + WS_G0) + (size_t)(seqtb + qb * 256) * 1024 + 512 + head * 64, nullptr, 0, 0, smem);
    } else {
      const int it = item - 2048;
      const int rq = it >> 3, head = it & 7;
      const int q0 = rq * 256;
      int tb, S; seq_of(q0, tb, S);
      const int rows = S >> 6, R0 = (q0 - tb) >> 6;
      const int rsA = min(max(R0 - 4, 0), rows - 8), rsB = min(max(R0 + 3 - 4, 0), rows - 8);
      attn_item<0>((const bf16_t*)(ws + WS_QA) + (size_t)q0 * 512 + head * 64, 512,
                   (const bf16_t*)(ws + WS_KA) + (size_t)tb * 512 + head * 64, 512, nullptr,
                   (const bf16_t*)(ws + WS_VAT) + (size_t)tb * 512 + (size_t)head * 64 * S, S, rsA, rsB + 8 - rsA,
                   (bf16_t*)(ws + WS_G0) + (size_t)q0 * 1024 + head * 64, (const float*)(ws + WS_TAB) + head * 15 * 128, R0, rows, smem);
    }
  }
  grid.sync();

  PH(3) {
    EpiOut epi{p.xp, p.xs, p.out, 0};
    for (int tile = vb; tile < 256 * 4; tile += gridDim.x)
      gemm_tile((const bf16_t*)(ws + WS_G0), 1024, (const bf16_t*)(ws + WS_WTO0), 1024, (tile >> 2) * 256, (tile & 3) * 256, smem, epi);
  }
  grid.sync();

  PH(4) { IDS() for (int t = gw; t < 32768; t += nw)
    rmsnorm_2rows_bf16(p.out + (size_t)t * 1024, p.out + (size_t)(t + 32768) * 1024, p.norm_o, (bf16_t*)(ws + WS_HB1) + (size_t)t * 1024, (bf16_t*)(ws + WS_HB1) + (size_t)(t + 32768) * 1024, lane);
  }
  grid.sync();

  PH(5) {
    Epi1 epi{ws};
    for (int tile = vb; tile < 256 * 7; tile += gridDim.x)
      gemm_tile((const bf16_t*)(ws + WS_HB1), 1024, (const bf16_t*)(ws + WS_WT1), 1024, (tile / 7) * 256, (tile % 7) * 256, smem, epi);
  }
  grid.sync();

  PH(6) { IDS() for (int t = gw; t < 65536; t += nw) {
    bf16_t* row = (bf16_t*)(ws + WS_LAT) + (size_t)t * 672;
    unsigned cq[3], ckv[2];
    float s1 = 0.f, s2 = 0.f;
#pragma unroll
    for (int j = 0; j < 3; ++j) { cq[j] = *(const unsigned*)(row + 2 * lane + 128 * j); const float a = bflo(cq[j]), b = bfhi(cq[j]); s1 += a * a + b * b; }
#pragma unroll
    for (int j = 0; j < 2; ++j) { ckv[j] = *(const unsigned*)(row + 384 + 2 * lane + 128 * j); const float a = bflo(ckv[j]), b = bfhi(ckv[j]); s2 += a * a + b * b; }
#pragma unroll
    for (int o = 32; o > 0; o >>= 1) { s1 += __shfl_xor(s1, o); s2 += __shfl_xor(s2, o); }
    const float r1 = rsqrtf(s1 * (1.f / 384.f) + 1e-6f), r2 = rsqrtf(s2 * (1.f / 256.f) + 1e-6f);
#pragma unroll
    for (int j = 0; j < 3; ++j) { const int c = 2 * lane + 128 * j; *(unsigned*)(row + c) = pk2(bflo(cq[j]) * r1 * p.qlat_g[c], bfhi(cq[j]) * r1 * p.qlat_g[c + 1]); }
#pragma unroll
    for (int j = 0; j < 2; ++j) { const int c = 2 * lane + 128 * j; *(unsigned*)(row + 384 + c) = pk2(bflo(ckv[j]) * r2 * p.kvlat_g[c], bfhi(ckv[j]) * r2 * p.kvlat_g[c + 1]); }
    if (lane < 16) {
      int tb, S; seq_of(t, tb, S);
      const int s = t - tb;
      const float x1 = bflo((unsigned)row[640 + lane]), x2 = bflo((unsigned)row[656 + lane]);
      const float inv = fexp2(-(float)(lane & 7) * (LOG2_THETA / 8.f));
      const float ang = (lane < 8 ? (float)(s >> 6) : (float)(s & 63)) * inv;
      const float c = __cosf(ang), sn = __sinf(ang);
      row[640 + lane] = (bf16_t)(pk2(x1 * c - x2 * sn, 0.f) & 0xffffu);
      row[656 + lane] = (bf16_t)(pk2(x1 * sn + x2 * c, 0.f) & 0xffffu);
    }
  } }
  grid.sync();

#pragma unroll 1
  for (int g = 0; g < 2; ++g) {
    const int gb = g * 32768;
    PH(7) {
      EpiUQ eq{ws, gb};
      EpiUKV ekv{ws, gb};
      for (int tile = vb; tile < 128 * 14; tile += gridDim.x) {
        const int tt = tile / 14, ct = tile % 14;
        if (ct < 6) gemm_tile((const bf16_t*)(ws + WS_LAT), 672, (const bf16_t*)(ws + WS_WTUQ), 384, gb + tt * 256, ct * 256, smem, eq);
        else gemm_tile((const bf16_t*)(ws + WS_LAT) + 384, 672, (const bf16_t*)(ws + WS_WTUKV), 256, gb + tt * 256, (ct - 6) * 256, smem, ekv);
      }
    }
    grid.sync();
    PH(8) for (int item = vb; item < 2048; item += gridDim.x) {
      int seqtb, S, head, qb;
      if (g == 0) { const int sq = item >> 8; head = (item >> 4) & 15; qb = item & 15; S = 4096; seqtb = sq * 4096; }
      else { const int sq = item >> 10; head = (item >> 6) & 15; qb = item & 63; S = 16384; seqtb = 32768 + sq * 16384; }
      attn_item<2>((const bf16_t*)(ws + WS_QC) + (size_t)(seqtb - gb + qb * 256) * 1536 + head * 96, 1536,
                   (const bf16_t*)(ws + WS_KN) + (size_t)(seqtb - gb) * 1024 + head * 64, 1024,
                   (const bf16_t*)(ws + WS_LAT) + (size_t)seqtb * 672 + 640,
                   (const bf16_t*)(ws + WS_VT) + (size_t)(seqtb - gb) * 1024 + (size_t)head * 64 * S, S, 0, S / 64,
                   (bf16_t*)(ws + WS_G1) + (size_t)(seqtb + qb * 256) * 1024 + head * 64, nullptr, 0, 0, smem);
    }
    grid.sync();
  }

  PH(9) {
    EpiOut epi{p.xp, p.xs, p.out, 1};
    for (int tile = vb; tile < 256 * 4; tile += gridDim.x)
      gemm_tile((const bf16_t*)(ws + WS_G1), 1024, (const bf16_t*)(ws + WS_WTO1), 1024, (tile >> 2) * 256, (tile & 3) * 256, smem, epi);
  }
  grid.sync();

  PH(10) { IDS() for (int t = gw; t < 32768; t += nw)
    rmsnorm_2rows_f32(p.out + (size_t)t * 1024, p.out + (size_t)(t + 32768) * 1024, p.norm_f, lane);
  }
}

extern "C" void kernel_launch(void* const* d_in, const int* in_sizes, int n_in,
                              void* d_out, int out_size, void* d_ws, size_t ws_size,
                              hipStream_t stream) {
  static int grid_blocks = 0;
  if (!grid_blocks) {
    int dev = 0, cus = 0, per_cu = 0;
    (void)hipGetDevice(&dev);
    (void)hipDeviceGetAttribute(&cus, hipDeviceAttributeMultiprocessorCount, dev);
    (void)hipOccupancyMaxActiveBlocksPerMultiprocessor(&per_cu, mega, 512, 0);
    per_cu = 1;
    grid_blocks = cus * per_cu;
  }
  if (ws_size < WS_NEED) { fprintf(stderr, "workspace too small: %zu\n", ws_size); return; }
  Params p{};
  p.xp = (const float*)d_in[0]; p.xs = (const float*)d_in[1];
  p.norm_e = (const float*)d_in[2]; p.w_in_e = (const float*)d_in[3]; p.rpb = (const float*)d_in[4];
  p.qn = (const float*)d_in[5]; p.kn = (const float*)d_in[6]; p.w_out_e = (const float*)d_in[7];
  p.norm_o = (const float*)d_in[8]; p.w_in_o = (const float*)d_in[9]; p.qlat_g = (const float*)d_in[10];
  p.kvlat_g = (const float*)d_in[11]; p.w_uq = (const float*)d_in[12]; p.w_ukv = (const float*)d_in[13];
  p.w_out_o = (const float*)d_in[14]; p.norm_f = (const float*)d_in[15];
  p.out = (float*)d_out; p.ws = (char*)d_ws;
  void* args[] = {&p};
  hipError_t e = hipLaunchCooperativeKernel((void*)mega, dim3(grid_blocks), dim3(512), args, 0, stream);
  if (e != hipSuccess) fprintf(stderr, "cooperative launch failed: %s (grid %d)\n", hipGetErrorString(e), grid_blocks);
}
```

```cpp
#include <hip/hip_runtime.h>
#include <hip/hip_cooperative_groups.h>
#include <cstdio>
namespace cg = cooperative_groups;

typedef unsigned short bf16_t;
using bf16x8 = __attribute__((ext_vector_type(8))) short;
using f32x16 = __attribute__((ext_vector_type(16))) float;
typedef __bf16 bf2_t __attribute__((ext_vector_type(2)));
typedef float f2_t __attribute__((ext_vector_type(2)));
typedef unsigned u32x4 __attribute__((ext_vector_type(4)));
#define DI __device__ __forceinline__
#define MFMA(a, b, c) __builtin_amdgcn_mfma_f32_32x32x16_bf16((a), (b), (c), 0, 0, 0)

#ifndef PHASE_MASK
#define PHASE_MASK 0xFFFF
#endif
#define PH(n) if ((PHASE_MASK >> (n)) & 1)
static constexpr size_t MiB = 1ull << 20;
static constexpr float LOG2E = 1.4426950408889634f;
static constexpr float LOG2_THETA = 13.287712379549449f;

DI unsigned pk2(float a, float b) { f2_t v = {a, b}; bf2_t o = __builtin_convertvector(v, bf2_t); return __builtin_bit_cast(unsigned, o); }
DI float bflo(unsigned u) { return __uint_as_float(u << 16); }
DI float bfhi(unsigned u) { return __uint_as_float(u & 0xffff0000u); }
DI float fexp2(float x) { return __builtin_amdgcn_exp2f(x); }
DI int crow(int i, int h) { return (i & 3) + 8 * (i >> 2) + 4 * h; }
DI float silu(float x) { return x / (1.f + __expf(-x)); }

struct Params {
  const float* xp; const float* xs;
  const float* norm_e; const float* w_in_e; const float* rpb; const float* qn; const float* kn; const float* w_out_e;
  const float* norm_o; const float* w_in_o; const float* qlat_g; const float* kvlat_g; const float* w_uq; const float* w_ukv;
  const float* w_out_o; const float* norm_f;
  float* out; char* ws;
};

#define WS_WT0   (0 * MiB)
#define WS_WTO0  (7 * MiB)
#define WS_WT1   (9 * MiB)
#define WS_WTUQ  (13 * MiB)
#define WS_WTUKV (15 * MiB)
#define WS_WTO1  (16 * MiB)
#define WS_TAB   (20 * MiB)
#define WS_QA    (32 * MiB)
#define WS_KA    (96 * MiB)
#define WS_VAT   (160 * MiB)
#define WS_QB    (224 * MiB)
#define WS_KB    (288 * MiB)
#define WS_VBT   (304 * MiB)
#define WS_G0    (320 * MiB)
#define WS_LAT   (32 * MiB)
#define WS_G1    (128 * MiB)
#define WS_HB1   (256 * MiB)
#define WS_QC    (256 * MiB)
#define WS_KN    (352 * MiB)
#define WS_VT    (416 * MiB)
#define WS_NEED  (480 * MiB)

DI void seq_of(int t, int& tb, int& S) {
  if (t < 32768) { S = 4096; tb = t & ~4095; } else { S = 16384; tb = 32768 + ((t - 32768) & ~16383); }
}

DI void store4(bf16_t* dst, float a, float b, float c, float d) {
  uint2 v; v.x = pk2(a, b); v.y = pk2(c, d); *(uint2*)dst = v;
}

DI void transpose_tile(const float* __restrict__ W, int N, int k0, int n0, bf16_t* __restrict__ WT, int K, int nrow_out, float* tile) {
  const int tid = threadIdx.x;
  const int nn = tid & 31, kq = (tid >> 5) & 7;
  if (tid < 256) {
#pragma unroll
    for (int j = 0; j < 8; ++j) { int kk = kq + 8 * j; tile[kk * 33 + nn] = W[(size_t)(k0 + kk) * N + n0 + nn]; }
  }
  __syncthreads();
  if (tid < 256) {
    const int nn2 = tid >> 3, kc = tid & 7;
    float v[8];
#pragma unroll
    for (int j = 0; j < 8; ++j) v[j] = tile[(kc * 8 + j) * 33 + nn2];
    uint4 o; o.x = pk2(v[0], v[1]); o.y = pk2(v[2], v[3]); o.z = pk2(v[4], v[5]); o.w = pk2(v[6], v[7]);
    *(uint4*)(WT + (size_t)(nrow_out + nn2) * K + k0 + kc * 8) = o;
  }
  __syncthreads();
}

DI void rmsnorm_row_bf16(const float* __restrict__ src, const float* __restrict__ g, bf16_t* __restrict__ dst, int lane) {
  float4 v[4]; float ss = 0.f;
#pragma unroll
  for (int i = 0; i < 4; ++i) { v[i] = *(const float4*)(src + i * 256 + lane * 4); ss += v[i].x * v[i].x + v[i].y * v[i].y + v[i].z * v[i].z + v[i].w * v[i].w; }
#pragma unroll
  for (int o = 32; o > 0; o >>= 1) ss += __shfl_xor(ss, o);
  const float rs = rsqrtf(ss * (1.f / 1024.f) + 1e-6f);
#pragma unroll
  for (int i = 0; i < 4; ++i) {
    float4 gg = *(const float4*)(g + i * 256 + lane * 4);
    store4(dst + i * 256 + lane * 4, v[i].x * rs * gg.x, v[i].y * rs * gg.y, v[i].z * rs * gg.z, v[i].w * rs * gg.w);
  }
}

DI void rmsnorm_2rows_bf16(const float* __restrict__ s0, const float* __restrict__ s1, const float* __restrict__ g,
                           bf16_t* __restrict__ d0, bf16_t* __restrict__ d1, int lane) {
  float4 a[4], b[4]; float sa = 0.f, sb = 0.f;
#pragma unroll
  for (int i = 0; i < 4; ++i) { a[i] = *(const float4*)(s0 + i * 256 + lane * 4); b[i] = *(const float4*)(s1 + i * 256 + lane * 4); }
#pragma unroll
  for (int i = 0; i < 4; ++i) {
    sa += a[i].x * a[i].x + a[i].y * a[i].y + a[i].z * a[i].z + a[i].w * a[i].w;
    sb += b[i].x * b[i].x + b[i].y * b[i].y + b[i].z * b[i].z + b[i].w * b[i].w;
  }
#pragma unroll
  for (int o = 32; o > 0; o >>= 1) { sa += __shfl_xor(sa, o); sb += __shfl_xor(sb, o); }
  const float ra = rsqrtf(sa * (1.f / 1024.f) + 1e-6f), rb = rsqrtf(sb * (1.f / 1024.f) + 1e-6f);
#pragma unroll
  for (int i = 0; i < 4; ++i) {
    const float4 gg = *(const float4*)(g + i * 256 + lane * 4);
    store4(d0 + i * 256 + lane * 4, a[i].x * ra * gg.x, a[i].y * ra * gg.y, a[i].z * ra * gg.z, a[i].w * ra * gg.w);
    store4(d1 + i * 256 + lane * 4, b[i].x * rb * gg.x, b[i].y * rb * gg.y, b[i].z * rb * gg.z, b[i].w * rb * gg.w);
  }
}
DI void rmsnorm_2rows_f32(float* __restrict__ d0, float* __restrict__ d1, const float* __restrict__ g, int lane) {
  float4 a[4], b[4]; float sa = 0.f, sb = 0.f;
#pragma unroll
  for (int i = 0; i < 4; ++i) { a[i] = *(const float4*)(d0 + i * 256 + lane * 4); b[i] = *(const float4*)(d1 + i * 256 + lane * 4); }
#pragma unroll
  for (int i = 0; i < 4; ++i) {
    sa += a[i].x * a[i].x + a[i].y * a[i].y + a[i].z * a[i].z + a[i].w * a[i].w;
    sb += b[i].x * b[i].x + b[i].y * b[i].y + b[i].z * b[i].z + b[i].w * b[i].w;
  }
#pragma unroll
  for (int o = 32; o > 0; o >>= 1) { sa += __shfl_xor(sa, o); sb += __shfl_xor(sb, o); }
  const float ra = rsqrtf(sa * (1.f / 1024.f) + 1e-6f), rb = rsqrtf(sb * (1.f / 1024.f) + 1e-6f);
#pragma unroll
  for (int i = 0; i < 4; ++i) {
    const float4 gg = *(const float4*)(g + i * 256 + lane * 4);
    float4 o; o.x = a[i].x * ra * gg.x; o.y = a[i].y * ra * gg.y; o.z = a[i].z * ra * gg.z; o.w = a[i].w * ra * gg.w;
    *(float4*)(d0 + i * 256 + lane * 4) = o;
    o.x = b[i].x * rb * gg.x; o.y = b[i].y * rb * gg.y; o.z = b[i].z * rb * gg.z; o.w = b[i].w * rb * gg.w;
    *(float4*)(d1 + i * 256 + lane * 4) = o;
  }
}

using f32x4 = __attribute__((ext_vector_type(4))) float;
DI int g8_lds_byte(int r, int c) {
  int st = (r >> 4) * 2 + (c >> 5), rr = r & 15, cc = c & 31, ob = rr * 64 + cc * 2;
  return st * 1024 + (ob ^ (((ob >> 9) & 1) << 5));
}
DI void g8_stage_rc(int b, int& R, int& C) {
  int st = b / 1024, sb = b % 1024, swz = sb ^ (((sb >> 9) & 1) << 5);
  R = (st >> 1) * 16 + swz / 64; C = (st & 1) * 32 + (swz % 64) / 2;
}
template <class Epi>
DI void gemm_tile(const bf16_t* __restrict__ Bt, int ldb, const bf16_t* __restrict__ A, int K, int bcol, int brow, char* smem, Epi epi) {
  constexpr int BK = 64, HALF = 128, HT = HALF * BK;
  bf16_t* shm = (bf16_t*)smem;
  const int lda = K;
#define G8_SA(b, h) (shm + ((b) * 2 + (h)) * HT)
#define G8_SB(b, h) (shm + (4 + (b) * 2 + (h)) * HT)
#define G8_STAGE(P, BASE, LD, OFF, br, kt) do { const bf16_t* _gp = (BASE) + ((long)(br) * (LD) + (long)(kt) * BK); \
    __builtin_amdgcn_global_load_lds((const unsigned*)(_gp + OFF##0), (__attribute__((address_space(3))) unsigned*)((char*)(P) + tid * 16), 16, 0, 0); \
    __builtin_amdgcn_global_load_lds((const unsigned*)(_gp + OFF##1), (__attribute__((address_space(3))) unsigned*)((char*)(P) + tid * 16 + 8192), 16, 0, 0); } while (0)
#define G8_LDA(dst, b, h) for (int m = 0; m < 4; ++m) for (int k = 0; k < 2; ++k) \
    dst[m][k] = *reinterpret_cast<const bf16x8*>((char*)G8_SA(b, h) + g8_lds_byte(wr * 64 + m * 16 + fr, k * 32 + fq * 8))
#define G8_LDB(dst, b, h) for (int n = 0; n < 2; ++n) for (int k = 0; k < 2; ++k) \
    dst[n][k] = *reinterpret_cast<const bf16x8*>((char*)G8_SB(b, h) + g8_lds_byte(wc * 32 + n * 16 + fr, k * 32 + fq * 8))
#define G8_MMA(ai, bj, At, Bt_) do { __builtin_amdgcn_s_setprio(1); \
    for (int m = 0; m < 4; ++m) for (int n = 0; n < 2; ++n) for (int k = 0; k < 2; ++k) \
      acc[ai][bj][m][n] = __builtin_amdgcn_mfma_f32_16x16x32_bf16(At[m][k], Bt_[n][k], acc[ai][bj][m][n], 0, 0, 0); \
    __builtin_amdgcn_s_setprio(0); } while (0)
#define G8_WAIT_V(n) asm volatile("s_waitcnt vmcnt(" #n ")" ::: "memory")
#define G8_WAIT_L(n) asm volatile("s_waitcnt lgkmcnt(" #n ")" ::: "memory")
#define G8_BAR __builtin_amdgcn_s_barrier()
#define G8_SCHED __builtin_amdgcn_sched_barrier(0)
  int tid = threadIdx.x;
  asm volatile("" : "+v"(tid));
  const int wid = tid >> 6, lane = tid & 63, wr = wid >> 2, wc = wid & 3, fr = lane & 15, fq = lane >> 4;
  unsigned offA0, offA1, offB0, offB1;
  { int r0, c0, r1, c1; g8_stage_rc(tid * 16, r0, c0); g8_stage_rc(tid * 16 + 8192, r1, c1);
    offA0 = r0 * lda + c0; offA1 = r1 * lda + c1; offB0 = r0 * ldb + c0; offB1 = r1 * ldb + c1; }
  f32x4 acc[2][2][4][2];
#pragma unroll
  for (int a = 0; a < 2; ++a)
#pragma unroll
    for (int b = 0; b < 2; ++b)
#pragma unroll
      for (int m = 0; m < 4; ++m)
#pragma unroll
        for (int n = 0; n < 2; ++n) { acc[a][b][m][n][0] = 0.f; acc[a][b][m][n][1] = 0.f; acc[a][b][m][n][2] = 0.f; acc[a][b][m][n][3] = 0.f; }
  bf16x8 At[4][2], B0[2][2], B1[2][2];
  const int nt = K / BK;
  __syncthreads();
  G8_STAGE(G8_SB(0, 0), Bt, ldb, offB, bcol, 0); G8_STAGE(G8_SA(0, 0), A, lda, offA, brow, 0);
  G8_STAGE(G8_SB(0, 1), Bt, ldb, offB, bcol + HALF, 0); G8_STAGE(G8_SA(0, 1), A, lda, offA, brow + HALF, 0);
  if (wr == 1) G8_BAR;
  G8_WAIT_V(4); G8_BAR;
  G8_STAGE(G8_SB(1, 0), Bt, ldb, offB, bcol, 1); G8_STAGE(G8_SA(1, 0), A, lda, offA, brow, 1); G8_STAGE(G8_SB(1, 1), Bt, ldb, offB, bcol + HALF, 1);
  G8_WAIT_V(6); G8_BAR;
  for (int t = 0; t < nt - 2; t += 2) {
    G8_LDB(B0, 0, 0); G8_SCHED; G8_LDA(At, 0, 0); G8_STAGE(G8_SA(1, 1), A, lda, offA, brow + HALF, t + 1);
    G8_WAIT_L(8); G8_BAR; G8_WAIT_L(0); G8_MMA(0, 0, At, B0); G8_BAR; G8_SCHED;
    G8_LDB(B1, 0, 1); G8_STAGE(G8_SB(0, 0), Bt, ldb, offB, bcol, t + 2);
    G8_BAR; G8_WAIT_L(0); G8_MMA(0, 1, At, B1); G8_BAR;
    G8_LDA(At, 0, 1); G8_STAGE(G8_SA(0, 0), A, lda, offA, brow, t + 2);
    G8_BAR; G8_WAIT_L(0); G8_MMA(1, 0, At, B0); G8_BAR; G8_SCHED;
    G8_STAGE(G8_SB(0, 1), Bt, ldb, offB, bcol + HALF, t + 2);
    G8_WAIT_V(6); G8_BAR; G8_MMA(1, 1, At, B1); G8_BAR;
    G8_LDB(B0, 1, 0); G8_SCHED; G8_LDA(At, 1, 0); G8_STAGE(G8_SA(0, 1), A, lda, offA, brow + HALF, t + 2);
    G8_WAIT_L(8); G8_BAR; G8_WAIT_L(0); G8_MMA(0, 0, At, B0); G8_BAR; G8_SCHED;
    G8_LDB(B1, 1, 1); G8_STAGE(G8_SB(1, 0), Bt, ldb, offB, bcol, t + 3);
    G8_BAR; G8_WAIT_L(0); G8_MMA(0, 1, At, B1); G8_BAR;
    G8_LDA(At, 1, 1); G8_STAGE(G8_SA(1, 0), A, lda, offA, brow, t + 3);
    G8_BAR; G8_WAIT_L(0); G8_MMA(1, 0, At, B0); G8_BAR; G8_SCHED;
    G8_STAGE(G8_SB(1, 1), Bt, ldb, offB, bcol + HALF, t + 3);
    G8_WAIT_V(6); G8_BAR; G8_MMA(1, 1, At, B1); G8_BAR;
  }
  { G8_LDB(B0, 0, 0); G8_LDA(At, 0, 0); G8_STAGE(G8_SA(1, 1), A, lda, offA, brow + HALF, nt - 1);
    G8_BAR; G8_WAIT_L(0); G8_MMA(0, 0, At, B0); G8_BAR;
    G8_LDB(B1, 0, 1); G8_BAR; G8_WAIT_L(0); G8_MMA(0, 1, At, B1); G8_BAR;
    G8_LDA(At, 0, 1); G8_WAIT_V(4); G8_BAR; G8_WAIT_L(0); G8_MMA(1, 0, At, B0); G8_MMA(1, 1, At, B1); G8_BAR; }
  { G8_LDB(B0, 1, 0); G8_LDA(At, 1, 0); G8_WAIT_V(2); G8_BAR; G8_WAIT_L(0); G8_MMA(0, 0, At, B0); G8_BAR;
    G8_LDB(B1, 1, 1); G8_WAIT_V(0); G8_BAR; G8_WAIT_L(0); G8_MMA(0, 1, At, B1); G8_BAR;
    G8_LDA(At, 1, 1); G8_BAR; G8_WAIT_L(0); G8_MMA(1, 0, At, B0); G8_MMA(1, 1, At, B1); G8_BAR; }
  if (wr == 0) G8_BAR;
  __syncthreads();
  char* stg = smem + wid * 8704;
#pragma unroll
  for (int ai = 0; ai < 2; ++ai)
#pragma unroll
    for (int bj = 0; bj < 2; ++bj)
      epi(acc[ai][bj], brow + ai * HALF + wr * 64, bcol + bj * HALF + wc * 32, fr, fq, stg);
}

static constexpr int STG_LD = 72;
static constexpr int STG_T = 40;
DI void stg_sync() { __builtin_amdgcn_fence(__ATOMIC_RELEASE, "wavefront"); __builtin_amdgcn_wave_barrier(); __builtin_amdgcn_fence(__ATOMIC_ACQUIRE, "wavefront"); }
DI void stg_rm4(bf16_t* stg, int tl, int ch, const f32x4& v, float sc) { store4(stg + tl * STG_LD + ch, v[0] * sc, v[1] * sc, v[2] * sc, v[3] * sc); }
DI void stg_tr4(bf16_t* stg, int tl, int ch, const f32x4& v) {
#pragma unroll
  for (int j = 0; j < 4; ++j) stg[(ch + j) * STG_T + tl] = (bf16_t)(pk2(v[j], 0.f) & 0xffffu);
}
template <int NCH>
DI void copy_out(const bf16_t* stg, bf16_t* dst, size_t ld, int lane) {
  constexpr int RPI = 64 / NCH;
#pragma unroll
  for (int j = 0; j < 32 / RPI; ++j) {
    const int row = lane / NCH + RPI * j, ch = lane % NCH;
    *(u32x4*)(dst + (size_t)row * ld + ch * 8) = *(const u32x4*)(stg + row * STG_LD + ch * 8);
  }
}
DI void copy_out_t(const bf16_t* stg, bf16_t* dst, size_t ld, int lane) {
#pragma unroll
  for (int j = 0; j < 4; ++j) {
    const int row = (lane >> 2) + 16 * j, ch = lane & 3;
    *(u32x4*)(dst + (size_t)row * ld + ch * 8) = *(const u32x4*)(stg + row * STG_T + ch * 8);
  }
}

struct Epi0 {
  char* ws; const float* qn; const float* kn;
  DI void operator()(f32x4 (&a)[4][2], int cb, int nb, int fr, int fq, char* stgc) const {
    bf16_t* stg = (bf16_t*)stgc;
    const int lane = fr + 16 * fq;
    int tb, S; seq_of(nb, tb, S);
    const int s0 = nb - tb;
    const bool tr = (cb >= 1024 && cb < 1536) || (cb >= 2176 && cb < 2304);
#pragma unroll
    for (int n = 0; n < 2; ++n) {
      const int tl = n * 16 + fr;
      const int s = s0 + tl;
      if (tr) {
#pragma unroll
        for (int m = 0; m < 4; ++m) stg_tr4(stg, tl, m * 16 + fq * 4, a[m][n]);
      } else if (cb < 1024) {
        const float sc = cb < 512 ? 0.125f * LOG2E : 1.f;
#pragma unroll
        for (int m = 0; m < 4; ++m) stg_rm4(stg, tl, m * 16 + fq * 4, a[m][n], sc);
      } else if (cb < 2176) {
        const bool isq = cb < 2048;
        const float* gsrc = isq ? qn : kn;
        float ss = 0.f;
#pragma unroll
        for (int m = 0; m < 4; ++m)
#pragma unroll
          for (int j = 0; j < 4; ++j) ss += a[m][n][j] * a[m][n][j];
        ss += __shfl_xor(ss, 16); ss += __shfl_xor(ss, 32);
        const float rs = rsqrtf(ss * (1.f / 64.f) + 1e-6f);
        const float frow = (float)(s >> 6), fcol = (float)(s & 63);
        const float osc = isq ? 0.125f * LOG2E : 1.f;
#pragma unroll
        for (int m = 0; m < 2; ++m) {
          f32x4 o1, o2;
#pragma unroll
          for (int j = 0; j < 4; ++j) {
            const int d1 = m * 16 + fq * 4 + j;
            const float x1 = a[m][n][j] * rs * gsrc[d1], x2 = a[m + 2][n][j] * rs * gsrc[d1 + 32];
            const float inv = fexp2(-(float)(d1 & 15) * (LOG2_THETA / 16.f));
            const float ang = (m == 0 ? frow : fcol) * inv;
            const float c = __cosf(ang), sn = __sinf(ang);
            o1[j] = (x1 * c - x2 * sn) * osc; o2[j] = (x1 * sn + x2 * c) * osc;
          }
          stg_rm4(stg, tl, m * 16 + fq * 4, o1, 1.f); stg_rm4(stg, tl, 32 + m * 16 + fq * 4, o2, 1.f);
        }
      } else {
#pragma unroll
        for (int m = 0; m < 4; ++m) {
          f32x4 o;
#pragma unroll
          for (int j = 0; j < 4; ++j) o[j] = silu(a[m][n][j]);
          stg_rm4(stg, tl, m * 16 + fq * 4, o, 1.f);
        }
      }
    }
    stg_sync();
    if (cb < 512) copy_out<8>(stg, (bf16_t*)(ws + WS_QA) + (size_t)nb * 512 + cb, 512, lane);
    else if (cb < 1024) copy_out<8>(stg, (bf16_t*)(ws + WS_KA) + (size_t)nb * 512 + (cb - 512), 512, lane);
    else if (cb < 1536) copy_out_t(stg, (bf16_t*)(ws + WS_VAT) + (size_t)tb * 512 + (size_t)(cb - 1024) * S + s0, S, lane);
    else if (cb < 2048) copy_out<8>(stg, (bf16_t*)(ws + WS_QB) + (size_t)nb * 512 + (cb - 1536), 512, lane);
    else if (cb < 2176) copy_out<8>(stg, (bf16_t*)(ws + WS_KB) + (size_t)nb * 128 + (cb - 2048), 128, lane);
    else if (cb < 2304) copy_out_t(stg, (bf16_t*)(ws + WS_VBT) + (size_t)tb * 128 + (size_t)(cb - 2176) * S + s0, S, lane);
    else copy_out<8>(stg, (bf16_t*)(ws + WS_G0) + (size_t)nb * 1024 + (cb - 2304), 1024, lane);
    stg_sync();
  }
};

struct Epi1 {
  char* ws;
  DI void operator()(f32x4 (&a)[4][2], int cb, int nb, int fr, int fq, char* stgc) const {
    bf16_t* stg = (bf16_t*)stgc;
    const int lane = fr + 16 * fq;
    if (cb >= 672 && cb < 768) return;
#pragma unroll
    for (int n = 0; n < 2; ++n) {
      const int tl = n * 16 + fr;
#pragma unroll
      for (int m = 0; m < 4; ++m) {
        if (cb < 768) stg_rm4(stg, tl, m * 16 + fq * 4, a[m][n], 1.f);
        else {
          f32x4 o;
#pragma unroll
          for (int j = 0; j < 4; ++j) o[j] = silu(a[m][n][j]);
          stg_rm4(stg, tl, m * 16 + fq * 4, o, 1.f);
        }
      }
    }
    stg_sync();
    if (cb == 640) copy_out<4>(stg, (bf16_t*)(ws + WS_LAT) + (size_t)nb * 672 + 640, 672, lane);
    else if (cb < 640) copy_out<8>(stg, (bf16_t*)(ws + WS_LAT) + (size_t)nb * 672 + cb, 672, lane);
    else copy_out<8>(stg, (bf16_t*)(ws + WS_G1) + (size_t)nb * 1024 + (cb - 768), 1024, lane);
    stg_sync();
  }
};

struct EpiUQ {
  char* ws; int gb;
  DI void operator()(f32x4 (&a)[4][2], int cb, int nb, int fr, int fq, char* stgc) const {
    bf16_t* stg = (bf16_t*)stgc;
    const int lane = fr + 16 * fq;
    const float osc = 0.10206207261596577f * LOG2E;
    int tb, S; seq_of(nb, tb, S);
#pragma unroll
    for (int n = 0; n < 2; ++n) {
      const int tl = n * 16 + fr;
      const int s = nb - tb + tl;
      const float frow = (float)(s >> 6), fcol = (float)(s & 63);
#pragma unroll
      for (int mp = 0; mp < 2; ++mp) {
        const int c32 = cb + 32 * mp;
        if ((c32 % 96) == 64) {
          f32x4 o1, o2;
#pragma unroll
          for (int j = 0; j < 4; ++j) {
            const int p = fq * 4 + j;
            const float inv = fexp2(-(float)(p & 7) * (LOG2_THETA / 8.f));
            const float ang = (p < 8 ? frow : fcol) * inv;
            const float c = __cosf(ang), sn = __sinf(ang);
            const float x1 = a[2 * mp][n][j], x2 = a[2 * mp + 1][n][j];
            o1[j] = x1 * c - x2 * sn; o2[j] = x1 * sn + x2 * c;
          }
          stg_rm4(stg, tl, 32 * mp + fq * 4, o1, osc); stg_rm4(stg, tl, 32 * mp + 16 + fq * 4, o2, osc);
        } else {
          stg_rm4(stg, tl, 32 * mp + fq * 4, a[2 * mp][n], osc); stg_rm4(stg, tl, 32 * mp + 16 + fq * 4, a[2 * mp + 1][n], osc);
        }
      }
    }
    stg_sync();
    copy_out<8>(stg, (bf16_t*)(ws + WS_QC) + (size_t)(nb - gb) * 1536 + cb, 1536, lane);
    stg_sync();
  }
};

struct EpiUKV {
  char* ws; int gb;
  DI void operator()(f32x4 (&a)[4][2], int cb, int nb, int fr, int fq, char* stgc) const {
    bf16_t* stg = (bf16_t*)stgc;
    const int lane = fr + 16 * fq;
    const int head = cb >> 7;
    int tb, S; seq_of(nb, tb, S);
    const bool isv = (cb & 64) != 0;
#pragma unroll
    for (int n = 0; n < 2; ++n) {
      const int tl = n * 16 + fr;
#pragma unroll
      for (int m = 0; m < 4; ++m) {
        if (!isv) stg_rm4(stg, tl, m * 16 + fq * 4, a[m][n], 1.f);
        else stg_tr4(stg, tl, m * 16 + fq * 4, a[m][n]);
      }
    }
    stg_sync();
    if (!isv) copy_out<8>(stg, (bf16_t*)(ws + WS_KN) + (size_t)(nb - gb) * 1024 + head * 64, 1024, lane);
    else copy_out_t(stg, (bf16_t*)(ws + WS_VT) + (size_t)(tb - gb) * 1024 + (size_t)head * 64 * S + (nb - tb), S, lane);
    stg_sync();
  }
};

struct EpiOut {
  const float* xp; const float* xs; float* out; int layer;
  DI void operator()(f32x4 (&a)[4][2], int cb, int nb, int fr, int fq, char* stgc) const {
    float* stg = (float*)stgc;
    const int lane = fr + 16 * fq;
#pragma unroll
    for (int n = 0; n < 2; ++n) {
      const int tl = n * 16 + fr;
#pragma unroll
      for (int m = 0; m < 4; ++m) *(f32x4*)(stg + tl * 68 + m * 16 + fq * 4) = a[m][n];
    }
    stg_sync();
    const float* res = layer == 0 ? (nb < 32768 ? xp + (size_t)nb * 1024 : xs + (size_t)(nb - 32768) * 1024) : out + (size_t)nb * 1024;
    float* dst = out + (size_t)nb * 1024;
#pragma unroll
    for (int j = 0; j < 8; ++j) {
      const int row = (lane >> 4) + 4 * j, c4 = (lane & 15) * 4;
      float4 v = *(const float4*)(stg + row * 68 + c4);
      const float4 rv = *(const float4*)(res + (size_t)row * 1024 + cb + c4);
      v.x += rv.x; v.y += rv.y; v.z += rv.z; v.w += rv.w;
      *(float4*)(dst + (size_t)row * 1024 + cb + c4) = v;
    }
    stg_sync();
  }
};

#define MFMA16(a, b, c) __builtin_amdgcn_mfma_f32_16x16x32_bf16((a), (b), (c), 0, 0, 0)
template <int MODE>
DI void attn_item(const bf16_t* __restrict__ Q, int ldq, const bf16_t* __restrict__ Kp, int ldk, const bf16_t* __restrict__ Kr,
                  const bf16_t* __restrict__ VT, int S, int tile0, int ntiles, bf16_t* __restrict__ G,
                  const float* __restrict__ rpb_h, int R0, int rows, char* smem) {
  constexpr int DQK = MODE == 2 ? 96 : 64;
  constexpr int NK2 = DQK / 32;
  constexpr int KLD = MODE == 2 ? 112 : 80;
  constexpr int VLD = 80;
  constexpr int NKC = MODE == 2 ? 2 : 1;
  constexpr int KBYTES = 64 * 112 * 2;
  constexpr int STAGE = KBYTES + 64 * VLD * 2;
  int tid = threadIdx.x;
  asm volatile("" : "+v"(tid));
  const int lane = tid & 63, w = tid >> 6, i16 = lane & 15, quad = lane >> 4;

  bf16x8 qf[2][NK2];
#pragma unroll
  for (int qb = 0; qb < 2; ++qb)
#pragma unroll
    for (int ks = 0; ks < NK2; ++ks) qf[qb][ks] = *(const bf16x8*)(Q + (size_t)(32 * w + 16 * qb + i16) * ldq + 32 * ks + 8 * quad);
  int rw = 0, rs = 0, qc0 = 0, cs0 = 0, cs1 = 0;
  if (MODE == 0) {
    rw = R0 + (w >> 1);
    rs = min(max(rw - 4, 0), rows - 8);
    qc0 = 32 * (w & 1) + i16;
    cs0 = min(max(qc0 - 8, 0), 48);
    cs1 = min(max(qc0 + 16 - 8, 0), 48);
  }
  f32x4 O[4][2];
#pragma unroll
  for (int db = 0; db < 4; ++db)
#pragma unroll
    for (int qb = 0; qb < 2; ++qb) { O[db][qb][0] = 0.f; O[db][qb][1] = 0.f; O[db][qb][2] = 0.f; O[db][qb][3] = 0.f; }
  float l0 = 0.f, l1 = 0.f, m0 = 0.f, m1 = 0.f;
  bool first = true, mzero = true;

  const bf16_t* kp[NKC]; const bf16_t* vp;
  int krow[NKC], kcol[NKC]; long kstep[NKC];
#pragma unroll
  for (int i = 0; i < NKC; ++i) {
    const int c = i == 0 ? tid : 512 + (tid & 255);
    if (MODE == 2) {
      const int row = c / 12, kc = c - 12 * row;
      krow[i] = row; kcol[i] = kc * 8;
      kp[i] = kc < 8 ? Kp + (size_t)(tile0 * 64 + row) * ldk + kc * 8 : Kr + (size_t)(tile0 * 64 + row) * 672 + (kc - 8) * 8;
      kstep[i] = kc < 8 ? (long)64 * ldk : (long)64 * 672;
    } else {
      const int row = c >> 3, kc = c & 7;
      krow[i] = row; kcol[i] = kc * 8;
      kp[i] = Kp + (size_t)(tile0 * 64 + row) * ldk + kc * 8;
      kstep[i] = (long)64 * ldk;
    }
  }
  const int vd = tid >> 3, vkc = tid & 7;
  vp = VT + (size_t)vd * S + tile0 * 64 + vkc * 8;
  const int vc4 = vkc & 3;
  const int vcol = 32 * (vkc >> 2) + (vc4 < 2 ? 16 * vc4 : 16 * (vc4 - 2) + 4);

  u32x4 kregA[NKC], vregA[1], kregB[NKC], vregB[1];
  auto prefetch = [&](u32x4 (&kreg)[NKC], u32x4 (&vreg)[1], bool adv) {
#pragma unroll
    for (int i = 0; i < NKC; ++i) { kreg[i] = *(const u32x4*)kp[i]; kp[i] += adv ? kstep[i] : 0; }
    vreg[0] = *(const u32x4*)vp; vp += adv ? 64 : 0;
  };
  auto stage_write = [&](char* st, u32x4 (&kreg)[NKC], u32x4 (&vreg)[1]) {
    bf16_t(*wK)[KLD] = (bf16_t(*)[KLD])st;
    bf16_t(*wV)[VLD] = (bf16_t(*)[VLD])(st + KBYTES);
#pragma unroll
    for (int i = 0; i < NKC; ++i) *(u32x4*)&wK[krow[i]][kcol[i]] = kreg[i];
    uint2 lo; lo.x = vreg[0].x; lo.y = vreg[0].y;
    uint2 hi; hi.x = vreg[0].z; hi.y = vreg[0].w;
    *(uint2*)&wV[vd][vcol] = lo;
    *(uint2*)&wV[vd][vcol + 8] = hi;
  };
  __syncthreads();
  prefetch(kregA, vregA, ntiles > 1);
  stage_write(smem, kregA, vregA);
  prefetch(kregB, vregB, ntiles > 2);
  __syncthreads();
  auto compute = [&](int tile, const char* st) {
    if (MODE != 0 || (tile >= rs && tile < rs + 8)) {
      const bf16_t(*sK)[KLD] = (const bf16_t(*)[KLD])st;
      const bf16_t(*sV)[VLD] = (const bf16_t(*)[VLD])(st + KBYTES);
      f32x4 s[4][2];
#pragma unroll
      for (int kb = 0; kb < 4; ++kb)
#pragma unroll
        for (int qb = 0; qb < 2; ++qb) { s[kb][qb][0] = 0.f; s[kb][qb][1] = 0.f; s[kb][qb][2] = 0.f; s[kb][qb][3] = 0.f; }
#pragma unroll
      for (int ks = 0; ks < NK2; ++ks)
#pragma unroll
        for (int kb = 0; kb < 4; ++kb) {
          const bf16x8 a = *(const bf16x8*)&sK[16 * kb + i16][32 * ks + 8 * quad];
          s[kb][0] = MFMA16(a, qf[0][ks], s[kb][0]);
          s[kb][1] = MFMA16(a, qf[1][ks], s[kb][1]);
        }
      bf16x8 va[2][4];
#pragma unroll
      for (int s2 = 0; s2 < 2; ++s2)
#pragma unroll
        for (int db = 0; db < 4; ++db) va[s2][db] = *(const bf16x8*)&sV[16 * db + i16][32 * s2 + 8 * quad];
      if (MODE == 0) {
        int mb0 = 4 * quad - cs0, mb1 = 4 * quad - cs1;
        asm volatile("" : "+v"(mb0), "+v"(mb1));
        const float* bp0 = rpb_h + (tile - rw + 7) * 128 + (4 * quad - qc0 + 63);
        const float* bp1 = bp0 - 16;
#pragma unroll
        for (int kb = 0; kb < 4; ++kb)
#pragma unroll
          for (int j = 0; j < 4; ++j) {
            const int ci = 16 * kb + j;
            const float b0 = bp0[ci], b1 = bp1[ci];
            s[kb][0][j] = ((unsigned)(mb0 + ci) < 16u) ? s[kb][0][j] + b0 : -1e30f;
            s[kb][1][j] = ((unsigned)(mb1 + ci) < 16u) ? s[kb][1][j] + b1 : -1e30f;
          }
      }
      bf16x8 pf[2][2]; float ps0, ps1;
      auto expsum = [&](float mm0, float mm1) {
        float a0 = 0.f, a1 = 0.f;
        u32x4 u00, u01, u10, u11;
#define EPQ(dlo, dhi, kb, qb, mm, acc_, OP) { const float e0 = fexp2(s[kb][qb][0] - mm), e1 = fexp2(s[kb][qb][1] - mm), e2 = fexp2(s[kb][qb][2] - mm), e3 = fexp2(s[kb][qb][3] - mm); \
          acc_ = (((acc_ OP e0) OP e1) OP e2) OP e3; dlo = pk2(e0, e1); dhi = pk2(e2, e3); }
        EPQ(u00.x, u00.y, 0, 0, mm0, a0, +) EPQ(u00.z, u00.w, 1, 0, mm0, a0, +) EPQ(u10.x, u10.y, 2, 0, mm0, a0, +) EPQ(u10.z, u10.w, 3, 0, mm0, a0, +)
        EPQ(u01.x, u01.y, 0, 1, mm1, a1, -) EPQ(u01.z, u01.w, 1, 1, mm1, a1, -) EPQ(u11.x, u11.y, 2, 1, mm1, a1, -) EPQ(u11.z, u11.w, 3, 1, mm1, a1, -)
#undef EPQ
        a1 = -a1;
        pf[0][0] = __builtin_bit_cast(bf16x8, u00); pf[0][1] = __builtin_bit_cast(bf16x8, u01);
        pf[1][0] = __builtin_bit_cast(bf16x8, u10); pf[1][1] = __builtin_bit_cast(bf16x8, u11);
        ps0 = a0; ps1 = a1;
      };
      if (mzero) expsum(0.f, 0.f); else expsum(m0, m1);
      if (__any((ps0 > 1.15e18f) || (ps1 > 1.15e18f) || (first && (ps0 < 8.7e-19f || ps1 < 8.7e-19f)))) {
        float t0 = s[0][0][0], t1 = s[0][1][0];
#pragma unroll
        for (int kb = 0; kb < 4; ++kb)
#pragma unroll
          for (int j = 0; j < 4; ++j) { t0 = fmaxf(t0, s[kb][0][j]); t1 = fmaxf(t1, s[kb][1][j]); }
        t0 = fmaxf(t0, __shfl_xor(t0, 16)); t0 = fmaxf(t0, __shfl_xor(t0, 32));
        t1 = fmaxf(t1, __shfl_xor(t1, 16)); t1 = fmaxf(t1, __shfl_xor(t1, 32));
        const float n0 = first ? t0 : fmaxf(m0, t0), n1 = first ? t1 : fmaxf(m1, t1);
        const float al0 = first ? 1.f : fexp2(m0 - n0), al1 = first ? 1.f : fexp2(m1 - n1);
        m0 = n0; m1 = n1; mzero = false;
        l0 *= al0; l1 *= al1;
#pragma unroll
        for (int db = 0; db < 4; ++db)
#pragma unroll
          for (int j = 0; j < 4; ++j) { O[db][0][j] *= al0; O[db][1][j] *= al1; }
        expsum(m0, m1);
      }
      first = false;
      l0 += ps0; l1 += ps1;
#pragma unroll
      for (int s2 = 0; s2 < 2; ++s2)
#pragma unroll
        for (int db = 0; db < 4; ++db) {
          O[db][0] = MFMA16(va[s2][db], pf[s2][0], O[db][0]);
          O[db][1] = MFMA16(va[s2][db], pf[s2][1], O[db][1]);
        }
    }
  };
  for (int tt = 0; tt < ntiles; tt += 2) {
    prefetch(kregA, vregA, tt + 3 < ntiles);
    compute(tile0 + tt, smem);
    stage_write(smem + STAGE, kregB, vregB);
    __syncthreads();
    if (tt + 1 < ntiles) {
      prefetch(kregB, vregB, tt + 4 < ntiles);
      compute(tile0 + tt + 1, smem + STAGE);
      stage_write(smem, kregA, vregA);
      __syncthreads();
    }
  }
  l0 += __shfl_xor(l0, 16); l0 += __shfl_xor(l0, 32);
  l1 += __shfl_xor(l1, 16); l1 += __shfl_xor(l1, 32);
  const float il0 = 1.f / l0, il1 = 1.f / l1;
#pragma unroll
  for (int qb = 0; qb < 2; ++qb) {
    const float il = qb == 0 ? il0 : il1;
    bf16_t* gp = G + (size_t)(32 * w + 16 * qb + i16) * 1024 + 4 * quad;
#pragma unroll
    for (int db = 0; db < 4; ++db) {
      bf16_t* p = gp + 16 * db;
      const uint2 gv = *(const uint2*)p;
      store4(p, O[db][qb][0] * il * bflo(gv.x), O[db][qb][1] * il * bfhi(gv.x), O[db][qb][2] * il * bflo(gv.y), O[db][qb][3] * il * bfhi(gv.y));
    }
  }
}

__global__ void __launch_bounds__(512) mega(Params p) {
  cg::grid_group grid = cg::this_grid();
  __shared__ __attribute__((aligned(16))) char smem[147456];
  const int nw = gridDim.x * 8;
#define IDS() int tid = threadIdx.x; asm volatile("" : "+v"(tid)); const int lane = tid & 63, wave = tid >> 6, gw = blockIdx.x * 8 + wave; (void)lane; (void)wave; (void)gw;
  char* ws = p.ws;
  const int vb = (gridDim.x & 7) == 0 ? (int)(blockIdx.x & 7) * (int)(gridDim.x >> 3) + (int)(blockIdx.x >> 3) : (int)blockIdx.x;

  PH(0) {
    IDS()
    for (int it = blockIdx.x; it < 4080; it += gridDim.x) {
      int i = it;
      float* tile = (float*)smem;
      if (i < 1664) { transpose_tile(p.w_in_e, 3328, (i / 104) * 64, (i % 104) * 32, (bf16_t*)(ws + WS_WT0), 1024, (i % 104) * 32, tile); continue; }
      i -= 1664;
      if (i < 512) { transpose_tile(p.w_out_e, 1024, (i / 32) * 64, (i % 32) * 32, (bf16_t*)(ws + WS_WTO0), 1024, (i % 32) * 32, tile); continue; }
      i -= 512;
      if (i < 848) { const int n0 = (i % 53) * 32; transpose_tile(p.w_in_o, 1696, (i / 53) * 64, n0, (bf16_t*)(ws + WS_WT1), 1024, n0 < 672 ? n0 : n0 + 96, tile); continue; }
      i -= 848;
      if (i < 288) { transpose_tile(p.w_uq, 1536, (i / 48) * 64, (i % 48) * 32, (bf16_t*)(ws + WS_WTUQ), 384, (i % 48) * 32, tile); continue; }
      i -= 288;
      if (i < 256) { transpose_tile(p.w_ukv, 2048, (i / 64) * 64, (i % 64) * 32, (bf16_t*)(ws + WS_WTUKV), 256, (i % 64) * 32, tile); continue; }
      i -= 256;
      transpose_tile(p.w_out_o, 1024, (i / 32) * 64, (i % 32) * 32, (bf16_t*)(ws + WS_WTO1), 1024, (i % 32) * 32, tile);
    }
    for (int i = blockIdx.x * 512 + tid; i < 96 * 1024 / 8; i += gridDim.x * 512) {
      uint4 z; z.x = z.y = z.z = z.w = 0u;
      *(uint4*)((bf16_t*)(ws + WS_WT1) + (size_t)672 * 1024 + (size_t)i * 8) = z;
    }
    for (int i = blockIdx.x * 512 + tid; i < 8 * 15 * 128; i += gridDim.x * 512) {
      const int j = i & 127, hd = i >> 7, off = j - 48;
      ((float*)(ws + WS_TAB))[i] = (off >= 0 && off <= 30) ? p.rpb[hd * 31 + off] * LOG2E : 0.f;
    }
    bf16_t* hb0 = (bf16_t*)p.out;
    for (int t = gw; t < 32768; t += nw)
      rmsnorm_2rows_bf16(p.xp + (size_t)t * 1024, p.xs + (size_t)t * 1024, p.norm_e, hb0 + (size_t)t * 1024, hb0 + (size_t)(t + 32768) * 1024, lane);
  }
  grid.sync();

  PH(1) {
    Epi0 epi{ws, p.qn, p.kn};
    for (int tile = vb; tile < 256 * 13; tile += gridDim.x)
      gemm_tile((const bf16_t*)p.out, 1024, (const bf16_t*)(ws + WS_WT0), 1024, (tile / 13) * 256, (tile % 13) * 256, smem, epi);
  }
  grid.sync();

  PH(2) for (int item = vb; item < 4096; item += gridDim.x) {
    if (item < 2048) {
      int seqtb, S, head, qb;
      if (item < 1024) { const int sq = item >> 9; head = (item >> 6) & 7; qb = item & 63; S = 16384; seqtb = 32768 + sq * 16384; }
      else { const int it = item - 1024; const int sq = it >> 7; head = (it >> 4) & 7; qb = it & 15; S = 4096; seqtb = sq * 4096; }
      const int kvh = head >> 2;
      attn_item<1>((const bf16_t*)(ws + WS_QB) + (size_t)(seqtb + qb * 256) * 512 + head * 64, 512,
                   (const bf16_t*)(ws + WS_KB) + (size_t)seqtb * 128 + kvh * 64, 128, nullptr,
                   (const bf16_t*)(ws + WS_VBT) + (size_t)seqtb * 128 + (size_t)kvh * 64 * S, S, 0, S / 64,
                   (bf16_t*)(ws + WS_G0) + (size_t)(seqtb + qb * 256) * 1024 + 512 + head * 64, nullptr, 0, 0, smem);
    } else {
      const int it = item - 2048;
      const int rq = it >> 3, head = it & 7;
      const int q0 = rq * 256;
      int tb, S; seq_of(q0, tb, S);
      const int rows = S >> 6, R0 = (q0 - tb) >> 6;
      const int rsA = min(max(R0 - 4, 0), rows - 8), rsB = min(max(R0 + 3 - 4, 0), rows - 8);
      attn_item<0>((const bf16_t*)(ws + WS_QA) + (size_t)q0 * 512 + head * 64, 512,
                   (const bf16_t*)(ws + WS_KA) + (size_t)tb * 512 + head * 64, 512, nullptr,
                   (const bf16_t*)(ws + WS_VAT) + (size_t)tb * 512 + (size_t)head * 64 * S, S, rsA, rsB + 8 - rsA,
                   (bf16_t*)(ws + WS_G0) + (size_t)q0 * 1024 + head * 64, (const float*)(ws + WS_TAB) + head * 15 * 128, R0, rows, smem);
    }
  }
  grid.sync();

  PH(3) {
    EpiOut epi{p.xp, p.xs, p.out, 0};
    for (int tile = vb; tile < 256 * 4; tile += gridDim.x)
      gemm_tile((const bf16_t*)(ws + WS_G0), 1024, (const bf16_t*)(ws + WS_WTO0), 1024, (tile >> 2) * 256, (tile & 3) * 256, smem, epi);
  }
  grid.sync();

  PH(4) { IDS() for (int t = gw; t < 32768; t += nw)
    rmsnorm_2rows_bf16(p.out + (size_t)t * 1024, p.out + (size_t)(t + 32768) * 1024, p.norm_o, (bf16_t*)(ws + WS_HB1) + (size_t)t * 1024, (bf16_t*)(ws + WS_HB1) + (size_t)(t + 32768) * 1024, lane);
  }
  grid.sync();

  PH(5) {
    Epi1 epi{ws};
    for (int tile = vb; tile < 256 * 7; tile += gridDim.x)
      gemm_tile((const bf16_t*)(ws + WS_HB1), 1024, (const bf16_t*)(ws + WS_WT1), 1024, (tile / 7) * 256, (tile % 7) * 256, smem, epi);
  }
  grid.sync();

  PH(6) { IDS() for (int t = gw; t < 65536; t += nw) {
    bf16_t* row = (bf16_t*)(ws + WS_LAT) + (size_t)t * 672;
    unsigned cq[3], ckv[2];
    float s1 = 0.f, s2 = 0.f;
#pragma unroll
    for (int j = 0; j < 3; ++j) { cq[j] = *(const unsigned*)(row + 2 * lane + 128 * j); const float a = bflo(cq[j]), b = bfhi(cq[j]); s1 += a * a + b * b; }
#pragma unroll
    for (int j = 0; j < 2; ++j) { ckv[j] = *(const unsigned*)(row + 384 + 2 * lane + 128 * j); const float a = bflo(ckv[j]), b = bfhi(ckv[j]); s2 += a * a + b * b; }
#pragma unroll
    for (int o = 32; o > 0; o >>= 1) { s1 += __shfl_xor(s1, o); s2 += __shfl_xor(s2, o); }
    const float r1 = rsqrtf(s1 * (1.f / 384.f) + 1e-6f), r2 = rsqrtf(s2 * (1.f / 256.f) + 1e-6f);
#pragma unroll
    for (int j = 0; j < 3; ++j) { const int c = 2 * lane + 128 * j; *(unsigned*)(row + c) = pk2(bflo(cq[j]) * r1 * p.qlat_g[c], bfhi(cq[j]) * r1 * p.qlat_g[c + 1]); }
#pragma unroll
    for (int j = 0; j < 2; ++j) { const int c = 2 * lane + 128 * j; *(unsigned*)(row + 384 + c) = pk2(bflo(ckv[j]) * r2 * p.kvlat_g[c], bfhi(ckv[j]) * r2 * p.kvlat_g[c + 1]); }
    if (lane < 16) {
      int tb, S; seq_of(t, tb, S);
      const int s = t - tb;
      const float x1 = bflo((unsigned)row[640 + lane]), x2 = bflo((unsigned)row[656 + lane]);
      const float inv = fexp2(-(float)(lane & 7) * (LOG2_THETA / 8.f));
      const float ang = (lane < 8 ? (float)(s >> 6) : (float)(s & 63)) * inv;
      const float c = __cosf(ang), sn = __sinf(ang);
      row[640 + lane] = (bf16_t)(pk2(x1 * c - x2 * sn, 0.f) & 0xffffu);
      row[656 + lane] = (bf16_t)(pk2(x1 * sn + x2 * c, 0.f) & 0xffffu);
    }
  } }
  grid.sync();

#pragma unroll 1
  for (int g = 0; g < 2; ++g) {
    const int gb = g * 32768;
    PH(7) {
      EpiUQ eq{ws, gb};
      EpiUKV ekv{ws, gb};
      for (int tile = vb; tile < 128 * 14; tile += gridDim.x) {
        const int tt = tile / 14, ct = tile % 14;
        if (ct < 6) gemm_tile((const bf16_t*)(ws + WS_LAT), 672, (const bf16_t*)(ws + WS_WTUQ), 384, gb + tt * 256, ct * 256, smem, eq);
        else gemm_tile((const bf16_t*)(ws + WS_LAT) + 384, 672, (const bf16_t*)(ws + WS_WTUKV), 256, gb + tt * 256, (ct - 6) * 256, smem, ekv);
      }
    }
    grid.sync();
    PH(8) for (int item = vb; item < 2048; item += gridDim.x) {
      int seqtb, S, head, qb;
      if (g == 0) { const int sq = item >> 8; head = (item >> 4) & 15; qb = item & 15; S = 4096; seqtb = sq * 4096; }
      else { const int sq = item >> 10; head = (item >> 6) & 15; qb = item & 63; S = 16384; seqtb = 32768 + sq * 16384; }
      attn_item<2>((const bf16_t*)(ws + WS_QC) + (size_t)(seqtb - gb + qb * 256) * 1536 + head * 96, 1536,
                   (const bf16_t*)(ws + WS_KN) + (size_t)(seqtb - gb) * 1024 + head * 64, 1024,
                   (const bf16_t*)(ws + WS_LAT) + (size_t)seqtb * 672 + 640,
                   (const bf16_t*)(ws + WS_VT) + (size_t)(seqtb - gb) * 1024 + (size_t)head * 64 * S, S, 0, S / 64,
                   (bf16_t*)(ws + WS_G1) + (size_t)(seqtb + qb * 256) * 1024 + head * 64, nullptr, 0, 0, smem);
    }
    grid.sync();
  }

  PH(9) {
    EpiOut epi{p.xp, p.xs, p.out, 1};
    for (int tile = vb; tile < 256 * 4; tile += gridDim.x)
      gemm_tile((const bf16_t*)(ws + WS_G1), 1024, (const bf16_t*)(ws + WS_WTO1), 1024, (tile >> 2) * 256, (tile & 3) * 256, smem, epi);
  }
  grid.sync();

  PH(10) { IDS() for (int t = gw; t < 32768; t += nw)
    rmsnorm_2rows_f32(p.out + (size_t)t * 1024, p.out + (size_t)(t + 32768) * 1024, p.norm_f, lane);
  }
}

extern "C" void kernel_launch(void* const* d_in, const int* in_sizes, int n_in,
                              void* d_out, int out_size, void* d_ws, size_t ws_size,
                              hipStream_t stream) {
  static int grid_blocks = 0;
  if (!grid_blocks) {
    int dev = 0, cus = 0, per_cu = 0;
    (void)hipGetDevice(&dev);
    (void)hipDeviceGetAttribute(&cus, hipDeviceAttributeMultiprocessorCount, dev);
    (void)hipOccupancyMaxActiveBlocksPerMultiprocessor(&per_cu, mega, 512, 0);
    per_cu = 1;
    grid_blocks = cus * per_cu;
  }
  if (ws_size < WS_NEED) { fprintf(stderr, "workspace too small: %zu\n", ws_size); return; }
  Params p{};
  p.xp = (const float*)d_in[0]; p.xs = (const float*)d_in[1];
  p.norm_e = (const float*)d_in[2]; p.w_in_e = (const float*)d_in[3]; p.rpb = (const float*)d_in[4];
  p.qn = (const float*)d_in[5]; p.kn = (const float*)d_in[6]; p.w_out_e = (const float*)d_in[7];
  p.norm_o = (const float*)d_in[8]; p.w_in_o = (const float*)d_in[9]; p.qlat_g = (const float*)d_in[10];
  p.kvlat_g = (const float*)d_in[11]; p.w_uq = (const float*)d_in[12]; p.w_ukv = (const float*)d_in[13];
  p.w_out_o = (const float*)d_in[14]; p.norm_f = (const float*)d_in[15];
  p.out = (float*)d_out; p.ws = (char*)d_ws;
  void* args[] = {&p};
  hipError_t e = hipLaunchCooperativeKernel((void*)mega, dim3(grid_blocks), dim3(512), args, 0, stream);
  if (e != hipSuccess) fprintf(stderr, "cooperative launch failed: %s (grid %d)\n", hipGetErrorString(e), grid_blocks);
}
```

```cpp
#include <hip/hip_runtime.h>
#include <hip/hip_cooperative_groups.h>
#include <cstdio>
namespace cg = cooperative_groups;

typedef unsigned short bf16_t;
using bf16x8 = __attribute__((ext_vector_type(8))) short;
using f32x16 = __attribute__((ext_vector_type(16))) float;
typedef __bf16 bf2_t __attribute__((ext_vector_type(2)));
typedef float f2_t __attribute__((ext_vector_type(2)));
typedef unsigned u32x4 __attribute__((ext_vector_type(4)));
#define DI __device__ __forceinline__
#define MFMA(a, b, c) __builtin_amdgcn_mfma_f32_32x32x16_bf16((a), (b), (c), 0, 0, 0)

#ifndef PHASE_MASK
#define PHASE_MASK 0xFFFF
#endif
#define PH(n) if ((PHASE_MASK >> (n)) & 1)
static constexpr size_t MiB = 1ull << 20;
static constexpr float LOG2E = 1.4426950408889634f;
static constexpr float LOG2_THETA = 13.287712379549449f;

DI unsigned pk2(float a, float b) { f2_t v = {a, b}; bf2_t o = __builtin_convertvector(v, bf2_t); return __builtin_bit_cast(unsigned, o); }
DI float bflo(unsigned u) { return __uint_as_float(u << 16); }
DI float bfhi(unsigned u) { return __uint_as_float(u & 0xffff0000u); }
DI float fexp2(float x) { return __builtin_amdgcn_exp2f(x); }
DI int crow(int i, int h) { return (i & 3) + 8 * (i >> 2) + 4 * h; }
DI float silu(float x) { return x / (1.f + __expf(-x)); }

struct Params {
  const float* xp; const float* xs;
  const float* norm_e; const float* w_in_e; const float* rpb; const float* qn; const float* kn; const float* w_out_e;
  const float* norm_o; const float* w_in_o; const float* qlat_g; const float* kvlat_g; const float* w_uq; const float* w_ukv;
  const float* w_out_o; const float* norm_f;
  float* out; char* ws;
};

#define WS_WT0   (0 * MiB)
#define WS_WTO0  (7 * MiB)
#define WS_WT1   (9 * MiB)
#define WS_WTUQ  (13 * MiB)
#define WS_WTUKV (15 * MiB)
#define WS_WTO1  (16 * MiB)
#define WS_TAB   (20 * MiB)
#define WS_QA    (32 * MiB)
#define WS_KA    (96 * MiB)
#define WS_VAT   (160 * MiB)
#define WS_QB    (224 * MiB)
#define WS_KB    (288 * MiB)
#define WS_VBT   (304 * MiB)
#define WS_G0    (320 * MiB)
#define WS_LAT   (32 * MiB)
#define WS_G1    (128 * MiB)
#define WS_HB1   (256 * MiB)
#define WS_QC    (256 * MiB)
#define WS_KN    (352 * MiB)
#define WS_VT    (416 * MiB)
#define WS_NEED  (480 * MiB)

DI void seq_of(int t, int& tb, int& S) {
  if (t < 32768) { S = 4096; tb = t & ~4095; } else { S = 16384; tb = 32768 + ((t - 32768) & ~16383); }
}

DI void store4(bf16_t* dst, float a, float b, float c, float d) {
  uint2 v; v.x = pk2(a, b); v.y = pk2(c, d); *(uint2*)dst = v;
}

DI void transpose_tile(const float* __restrict__ W, int N, int k0, int n0, bf16_t* __restrict__ WT, int K, int nrow_out, float* tile) {
  const int tid = threadIdx.x;
  const int nn = tid & 31, kq = (tid >> 5) & 7;
  if (tid < 256) {
#pragma unroll
    for (int j = 0; j < 8; ++j) { int kk = kq + 8 * j; tile[kk * 33 + nn] = W[(size_t)(k0 + kk) * N + n0 + nn]; }
  }
  __syncthreads();
  if (tid < 256) {
    const int nn2 = tid >> 3, kc = tid & 7;
    float v[8];
#pragma unroll
    for (int j = 0; j < 8; ++j) v[j] = tile[(kc * 8 + j) * 33 + nn2];
    uint4 o; o.x = pk2(v[0], v[1]); o.y = pk2(v[2], v[3]); o.z = pk2(v[4], v[5]); o.w = pk2(v[6], v[7]);
    *(uint4*)(WT + (size_t)(nrow_out + nn2) * K + k0 + kc * 8) = o;
  }
  __syncthreads();
}

DI void rmsnorm_row_bf16(const float* __restrict__ src, const float* __restrict__ g, bf16_t* __restrict__ dst, int lane) {
  float4 v[4]; float ss = 0.f;
#pragma unroll
  for (int i = 0; i < 4; ++i) { v[i] = *(const float4*)(src + i * 256 + lane * 4); ss += v[i].x * v[i].x + v[i].y * v[i].y + v[i].z * v[i].z + v[i].w * v[i].w; }
#pragma unroll
  for (int o = 32; o > 0; o >>= 1) ss += __shfl_xor(ss, o);
  const float rs = rsqrtf(ss * (1.f / 1024.f) + 1e-6f);
#pragma unroll
  for (int i = 0; i < 4; ++i) {
    float4 gg = *(const float4*)(g + i * 256 + lane * 4);
    store4(dst + i * 256 + lane * 4, v[i].x * rs * gg.x, v[i].y * rs * gg.y, v[i].z * rs * gg.z, v[i].w * rs * gg.w);
  }
}

DI void rmsnorm_2rows_bf16(const float* __restrict__ s0, const float* __restrict__ s1, const float* __restrict__ g,
                           bf16_t* __restrict__ d0, bf16_t* __restrict__ d1, int lane) {
  float4 a[4], b[4]; float sa = 0.f, sb = 0.f;
#pragma unroll
  for (int i = 0; i < 4; ++i) { a[i] = *(const float4*)(s0 + i * 256 + lane * 4); b[i] = *(const float4*)(s1 + i * 256 + lane * 4); }
#pragma unroll
  for (int i = 0; i < 4; ++i) {
    sa += a[i].x * a[i].x + a[i].y * a[i].y + a[i].z * a[i].z + a[i].w * a[i].w;
    sb += b[i].x * b[i].x + b[i].y * b[i].y + b[i].z * b[i].z + b[i].w * b[i].w;
  }
#pragma unroll
  for (int o = 32; o > 0; o >>= 1) { sa += __shfl_xor(sa, o); sb += __shfl_xor(sb, o); }
  const float ra = rsqrtf(sa * (1.f / 1024.f) + 1e-6f), rb = rsqrtf(sb * (1.f / 1024.f) + 1e-6f);
#pragma unroll
  for (int i = 0; i < 4; ++i) {
    const float4 gg = *(const float4*)(g + i * 256 + lane * 4);
    store4(d0 + i * 256 + lane * 4, a[i].x * ra * gg.x, a[i].y * ra * gg.y, a[i].z * ra * gg.z, a[i].w * ra * gg.w);
    store4(d1 + i * 256 + lane * 4, b[i].x * rb * gg.x, b[i].y * rb * gg.y, b[i].z * rb * gg.z, b[i].w * rb * gg.w);
  }
}
DI void rmsnorm_2rows_f32(float* __restrict__ d0, float* __restrict__ d1, const float* __restrict__ g, int lane) {
  float4 a[4], b[4]; float sa = 0.f, sb = 0.f;
#pragma unroll
  for (int i = 0; i < 4; ++i) { a[i] = *(const float4*)(d0 + i * 256 + lane * 4); b[i] = *(const float4*)(d1 + i * 256 + lane * 4); }
#pragma unroll
  for (int i = 0; i < 4; ++i) {
    sa += a[i].x * a[i].x + a[i].y * a[i].y + a[i].z * a[i].z + a[i].w * a[i].w;
    sb += b[i].x * b[i].x + b[i].y * b[i].y + b[i].z * b[i].z + b[i].w * b[i].w;
  }
#pragma unroll
  for (int o = 32; o > 0; o >>= 1) { sa += __shfl_xor(sa, o); sb += __shfl_xor(sb, o); }
  const float ra = rsqrtf(sa * (1.f / 1024.f) + 1e-6f), rb = rsqrtf(sb * (1.f / 1024.f) + 1e-6f);
#pragma unroll
  for (int i = 0; i < 4; ++i) {
    const float4 gg = *(const float4*)(g + i * 256 + lane * 4);
    float4 o; o.x = a[i].x * ra * gg.x; o.y = a[i].y * ra * gg.y; o.z = a[i].z * ra * gg.z; o.w = a[i].w * ra * gg.w;
    *(float4*)(d0 + i * 256 + lane * 4) = o;
    o.x = b[i].x * rb * gg.x; o.y = b[i].y * rb * gg.y; o.z = b[i].z * rb * gg.z; o.w = b[i].w * rb * gg.w;
    *(float4*)(d1 + i * 256 + lane * 4) = o;
  }
}

using f32x4 = __attribute__((ext_vector_type(4))) float;
DI int g8_lds_byte(int r, int c) {
  int st = (r >> 4) * 2 + (c >> 5), rr = r & 15, cc = c & 31, ob = rr * 64 + cc * 2;
  return st * 1024 + (ob ^ (((ob >> 9) & 1) << 5));
}
DI void g8_stage_rc(int b, int& R, int& C) {
  int st = b / 1024, sb = b % 1024, swz = sb ^ (((sb >> 9) & 1) << 5);
  R = (st >> 1) * 16 + swz / 64; C = (st & 1) * 32 + (swz % 64) / 2;
}
template <class Epi>
DI void gemm_tile(const bf16_t* __restrict__ Bt, int ldb, const bf16_t* __restrict__ A, int K, int bcol, int brow, char* smem, Epi epi) {
  constexpr int BK = 64, HALF = 128, HT = HALF * BK;
  bf16_t* shm = (bf16_t*)smem;
  const int lda = K;
#define G8_SA(b, h) (shm + ((b) * 2 + (h)) * HT)
#define G8_SB(b, h) (shm + (4 + (b) * 2 + (h)) * HT)
#define G8_STAGE(P, BASE, LD, OFF, br, kt) do { const bf16_t* _gp = (BASE) + ((long)(br) * (LD) + (long)(kt) * BK); \
    __builtin_amdgcn_global_load_lds((const unsigned*)(_gp + OFF##0), (__attribute__((address_space(3))) unsigned*)((char*)(P) + tid * 16), 16, 0, 0); \
    __builtin_amdgcn_global_load_lds((const unsigned*)(_gp + OFF##1), (__attribute__((address_space(3))) unsigned*)((char*)(P) + tid * 16 + 8192), 16, 0, 0); } while (0)
#define G8_LDA(dst, b, h) for (int m = 0; m < 4; ++m) for (int k = 0; k < 2; ++k) \
    dst[m][k] = *reinterpret_cast<const bf16x8*>((char*)G8_SA(b, h) + g8_lds_byte(wr * 64 + m * 16 + fr, k * 32 + fq * 8))
#define G8_LDB(dst, b, h) for (int n = 0; n < 2; ++n) for (int k = 0; k < 2; ++k) \
    dst[n][k] = *reinterpret_cast<const bf16x8*>((char*)G8_SB(b, h) + g8_lds_byte(wc * 32 + n * 16 + fr, k * 32 + fq * 8))
#define G8_MMA(ai, bj, At, Bt_) do { __builtin_amdgcn_s_setprio(1); \
    for (int m = 0; m < 4; ++m) for (int n = 0; n < 2; ++n) for (int k = 0; k < 2; ++k) \
      acc[ai][bj][m][n] = __builtin_amdgcn_mfma_f32_16x16x32_bf16(At[m][k], Bt_[n][k], acc[ai][bj][m][n], 0, 0, 0); \
    __builtin_amdgcn_s_setprio(0); } while (0)
#define G8_WAIT_V(n) asm volatile("s_waitcnt vmcnt(" #n ")" ::: "memory")
#define G8_WAIT_L(n) asm volatile("s_waitcnt lgkmcnt(" #n ")" ::: "memory")
#define G8_BAR __builtin_amdgcn_s_barrier()
#define G8_SCHED __builtin_amdgcn_sched_barrier(0)
  int tid = threadIdx.x;
  asm volatile("" : "+v"(tid));
  const int wid = tid >> 6, lane = tid & 63, wr = wid >> 2, wc = wid & 3, fr = lane & 15, fq = lane >> 4;
  unsigned offA0, offA1, offB0, offB1;
  { int r0, c0, r1, c1; g8_stage_rc(tid * 16, r0, c0); g8_stage_rc(tid * 16 + 8192, r1, c1);
    offA0 = r0 * lda + c0; offA1 = r1 * lda + c1; offB0 = r0 * ldb + c0; offB1 = r1 * ldb + c1; }
  f32x4 acc[2][2][4][2];
#pragma unroll
  for (int a = 0; a < 2; ++a)
#pragma unroll
    for (int b = 0; b < 2; ++b)
#pragma unroll
      for (int m = 0; m < 4; ++m)
#pragma unroll
        for (int n = 0; n < 2; ++n) { acc[a][b][m][n][0] = 0.f; acc[a][b][m][n][1] = 0.f; acc[a][b][m][n][2] = 0.f; acc[a][b][m][n][3] = 0.f; }
  bf16x8 At[4][2], B0[2][2], B1[2][2];
  const int nt = K / BK;
  __syncthreads();
  G8_STAGE(G8_SB(0, 0), Bt, ldb, offB, bcol, 0); G8_STAGE(G8_SA(0, 0), A, lda, offA, brow, 0);
  G8_STAGE(G8_SB(0, 1), Bt, ldb, offB, bcol + HALF, 0); G8_STAGE(G8_SA(0, 1), A, lda, offA, brow + HALF, 0);
  if (wr == 1) G8_BAR;
  G8_WAIT_V(4); G8_BAR;
  G8_STAGE(G8_SB(1, 0), Bt, ldb, offB, bcol, 1); G8_STAGE(G8_SA(1, 0), A, lda, offA, brow, 1); G8_STAGE(G8_SB(1, 1), Bt, ldb, offB, bcol + HALF, 1);
  G8_WAIT_V(6); G8_BAR;
  for (int t = 0; t < nt - 2; t += 2) {
    G8_LDB(B0, 0, 0); G8_SCHED; G8_LDA(At, 0, 0); G8_STAGE(G8_SA(1, 1), A, lda, offA, brow + HALF, t + 1);
    G8_WAIT_L(8); G8_BAR; G8_WAIT_L(0); G8_MMA(0, 0, At, B0); G8_BAR; G8_SCHED;
    G8_LDB(B1, 0, 1); G8_STAGE(G8_SB(0, 0), Bt, ldb, offB, bcol, t + 2);
    G8_BAR; G8_WAIT_L(0); G8_MMA(0, 1, At, B1); G8_BAR;
    G8_LDA(At, 0, 1); G8_STAGE(G8_SA(0, 0), A, lda, offA, brow, t + 2);
    G8_BAR; G8_WAIT_L(0); G8_MMA(1, 0, At, B0); G8_BAR; G8_SCHED;
    G8_STAGE(G8_SB(0, 1), Bt, ldb, offB, bcol + HALF, t + 2);
    G8_WAIT_V(6); G8_BAR; G8_MMA(1, 1, At, B1); G8_BAR;
    G8_LDB(B0, 1, 0); G8_SCHED; G8_LDA(At, 1, 0); G8_STAGE(G8_SA(0, 1), A, lda, offA, brow + HALF, t + 2);
    G8_WAIT_L(8); G8_BAR; G8_WAIT_L(0); G8_MMA(0, 0, At, B0); G8_BAR; G8_SCHED;
    G8_LDB(B1, 1, 1); G8_STAGE(G8_SB(1, 0), Bt, ldb, offB, bcol, t + 3);
    G8_BAR; G8_WAIT_L(0); G8_MMA(0, 1, At, B1); G8_BAR;
    G8_LDA(At, 1, 1); G8_STAGE(G8_SA(1, 0), A, lda, offA, brow, t + 3);
    G8_BAR; G8_WAIT_L(0); G8_MMA(1, 0, At, B0); G8_BAR; G8_SCHED;
    G8_STAGE(G8_SB(1, 1), Bt, ldb, offB, bcol + HALF, t + 3);
    G8_WAIT_V(6); G8_BAR; G8_MMA(1, 1, At, B1); G8_BAR;
  }
  { G8_LDB(B0, 0, 0); G8_LDA(At, 0, 0); G8_STAGE(G8_SA(1, 1), A, lda, offA, brow + HALF, nt - 1);
    G8_BAR; G8_WAIT_L(0); G8_MMA(0, 0, At, B0); G8_BAR;
    G8_LDB(B1, 0, 1); G8_BAR; G8_WAIT_L(0); G8_MMA(0, 1, At, B1); G8_BAR;
    G8_LDA(At, 0, 1); G8_WAIT_V(4); G8_BAR; G8_WAIT_L(0); G8_MMA(1, 0, At, B0); G8_MMA(1, 1, At, B1); G8_BAR; }
  { G8_LDB(B0, 1, 0); G8_LDA(At, 1, 0); G8_WAIT_V(2); G8_BAR; G8_WAIT_L(0); G8_MMA(0, 0, At, B0); G8_BAR;
    G8_LDB(B1, 1, 1); G8_WAIT_V(0); G8_BAR; G8_WAIT_L(0); G8_MMA(0, 1, At, B1); G8_BAR;
    G8_LDA(At, 1, 1); G8_BAR; G8_WAIT_L(0); G8_MMA(1, 0, At, B0); G8_MMA(1, 1, At, B1); G8_BAR; }
  if (wr == 0) G8_BAR;
  __syncthreads();
  char* stg = smem + wid * 8704;
#pragma unroll
  for (int ai = 0; ai < 2; ++ai)
#pragma unroll
    for (int bj = 0; bj < 2; ++bj)
      epi(acc[ai][bj], brow + ai * HALF + wr * 64, bcol + bj * HALF + wc * 32, fr, fq, stg);
}

static constexpr int STG_LD = 72;
static constexpr int STG_T = 40;
DI void stg_sync() { __builtin_amdgcn_fence(__ATOMIC_RELEASE, "wavefront"); __builtin_amdgcn_wave_barrier(); __builtin_amdgcn_fence(__ATOMIC_ACQUIRE, "wavefront"); }
DI void stg_rm4(bf16_t* stg, int tl, int ch, const f32x4& v, float sc) { store4(stg + tl * STG_LD + ch, v[0] * sc, v[1] * sc, v[2] * sc, v[3] * sc); }
DI void stg_tr4(bf16_t* stg, int tl, int ch, const f32x4& v) {
#pragma unroll
  for (int j = 0; j < 4; ++j) stg[(ch + j) * STG_T + tl] = (bf16_t)(pk2(v[j], 0.f) & 0xffffu);
}
template <int NCH>
DI void copy_out(const bf16_t* stg, bf16_t* dst, size_t ld, int lane) {
  constexpr int RPI = 64 / NCH;
#pragma unroll
  for (int j = 0; j < 32 / RPI; ++j) {
    const int row = lane / NCH + RPI * j, ch = lane % NCH;
    *(u32x4*)(dst + (size_t)row * ld + ch * 8) = *(const u32x4*)(stg + row * STG_LD + ch * 8);
  }
}
DI void copy_out_t(const bf16_t* stg, bf16_t* dst, size_t ld, int lane) {
#pragma unroll
  for (int j = 0; j < 4; ++j) {
    const int row = (lane >> 2) + 16 * j, ch = lane & 3;
    *(u32x4*)(dst + (size_t)row * ld + ch * 8) = *(const u32x4*)(stg + row * STG_T + ch * 8);
  }
}

struct Epi0 {
  char* ws; const float* qn; const float* kn;
  DI void operator()(f32x4 (&a)[4][2], int cb, int nb, int fr, int fq, char* stgc) const {
    bf16_t* stg = (bf16_t*)stgc;
    const int lane = fr + 16 * fq;
    int tb, S; seq_of(nb, tb, S);
    const int s0 = nb - tb;
    const bool tr = (cb >= 1024 && cb < 1536) || (cb >= 2176 && cb < 2304);
#pragma unroll
    for (int n = 0; n < 2; ++n) {
      const int tl = n * 16 + fr;
      const int s = s0 + tl;
      if (tr) {
#pragma unroll
        for (int m = 0; m < 4; ++m) stg_tr4(stg, tl, m * 16 + fq * 4, a[m][n]);
      } else if (cb < 1024) {
        const float sc = cb < 512 ? 0.125f * LOG2E : 1.f;
#pragma unroll
        for (int m = 0; m < 4; ++m) stg_rm4(stg, tl, m * 16 + fq * 4, a[m][n], sc);
      } else if (cb < 2176) {
        const bool isq = cb < 2048;
        const float* gsrc = isq ? qn : kn;
        float ss = 0.f;
#pragma unroll
        for (int m = 0; m < 4; ++m)
#pragma unroll
          for (int j = 0; j < 4; ++j) ss += a[m][n][j] * a[m][n][j];
        ss += __shfl_xor(ss, 16); ss += __shfl_xor(ss, 32);
        const float rs = rsqrtf(ss * (1.f / 64.f) + 1e-6f);
        const float frow = (float)(s >> 6), fcol = (float)(s & 63);
        const float osc = isq ? 0.125f * LOG2E : 1.f;
#pragma unroll
        for (int m = 0; m < 2; ++m) {
          f32x4 o1, o2;
#pragma unroll
          for (int j = 0; j < 4; ++j) {
            const int d1 = m * 16 + fq * 4 + j;
            const float x1 = a[m][n][j] * rs * gsrc[d1], x2 = a[m + 2][n][j] * rs * gsrc[d1 + 32];
            const float inv = fexp2(-(float)(d1 & 15) * (LOG2_THETA / 16.f));
            const float ang = (m == 0 ? frow : fcol) * inv;
            const float c = __cosf(ang), sn = __sinf(ang);
            o1[j] = (x1 * c - x2 * sn) * osc; o2[j] = (x1 * sn + x2 * c) * osc;
          }
          stg_rm4(stg, tl, m * 16 + fq * 4, o1, 1.f); stg_rm4(stg, tl, 32 + m * 16 + fq * 4, o2, 1.f);
        }
      } else {
#pragma unroll
        for (int m = 0; m < 4; ++m) {
          f32x4 o;
#pragma unroll
          for (int j = 0; j < 4; ++j) o[j] = silu(a[m][n][j]);
          stg_rm4(stg, tl, m * 16 + fq * 4, o, 1.f);
        }
      }
    }
    stg_sync();
    if (cb < 512) copy_out<8>(stg, (bf16_t*)(ws + WS_QA) + (size_t)nb * 512 + cb, 512, lane);
    else if (cb < 1024) copy_out<8>(stg, (bf16_t*)(ws + WS_KA) + (size_t)nb * 512 + (cb - 512), 512, lane);
    else if (cb < 1536) copy_out_t(stg, (bf16_t*)(ws + WS_VAT) + (size_t)tb * 512 + (size_t)(cb - 1024) * S + s0, S, lane);
    else if (cb < 2048) copy_out<8>(stg, (bf16_t*)(ws + WS_QB) + (size_t)nb * 512 + (cb - 1536), 512, lane);
    else if (cb < 2176) copy_out<8>(stg, (bf16_t*)(ws + WS_KB) + (size_t)nb * 128 + (cb - 2048), 128, lane);
    else if (cb < 2304) copy_out_t(stg, (bf16_t*)(ws + WS_VBT) + (size_t)tb * 128 + (size_t)(cb - 2176) * S + s0, S, lane);
    else copy_out<8>(stg, (bf16_t*)(ws + WS_G0) + (size_t)nb * 1024 + (cb - 2304), 1024, lane);
    stg_sync();
  }
};

struct Epi1 {
  char* ws;
  DI void operator()(f32x4 (&a)[4][2], int cb, int nb, int fr, int fq, char* stgc) const {
    bf16_t* stg = (bf16_t*)stgc;
    const int lane = fr + 16 * fq;
    if (cb >= 672 && cb < 768) return;
#pragma unroll
    for (int n = 0; n < 2; ++n) {
      const int tl = n * 16 + fr;
#pragma unroll
      for (int m = 0; m < 4; ++m) {
        if (cb < 768) stg_rm4(stg, tl, m * 16 + fq * 4, a[m][n], 1.f);
        else {
          f32x4 o;
#pragma unroll
          for (int j = 0; j < 4; ++j) o[j] = silu(a[m][n][j]);
          stg_rm4(stg, tl, m * 16 + fq * 4, o, 1.f);
        }
      }
    }
    stg_sync();
    if (cb == 640) copy_out<4>(stg, (bf16_t*)(ws + WS_LAT) + (size_t)nb * 672 + 640, 672, lane);
    else if (cb < 640) copy_out<8>(stg, (bf16_t*)(ws + WS_LAT) + (size_t)nb * 672 + cb, 672, lane);
    else copy_out<8>(stg, (bf16_t*)(ws + WS_G1) + (size_t)nb * 1024 + (cb - 768), 1024, lane);
    stg_sync();
  }
};

struct EpiUQ {
  char* ws; int gb;
  DI void operator()(f32x4 (&a)[4][2], int cb, int nb, int fr, int fq, char* stgc) const {
    bf16_t* stg = (bf16_t*)stgc;
    const int lane = fr + 16 * fq;
    const float osc = 0.10206207261596577f * LOG2E;
    int tb, S; seq_of(nb, tb, S);
#pragma unroll
    for (int n = 0; n < 2; ++n) {
      const int tl = n * 16 + fr;
      const int s = nb - tb + tl;
      const float frow = (float)(s >> 6), fcol = (float)(s & 63);
#pragma unroll
      for (int mp = 0; mp < 2; ++mp) {
        const int c32 = cb + 32 * mp;
        if ((c32 % 96) == 64) {
          f32x4 o1, o2;
#pragma unroll
          for (int j = 0; j < 4; ++j) {
            const int p = fq * 4 + j;
            const float inv = fexp2(-(float)(p & 7) * (LOG2_THETA / 8.f));
            const float ang = (p < 8 ? frow : fcol) * inv;
            const float c = __cosf(ang), sn = __sinf(ang);
            const float x1 = a[2 * mp][n][j], x2 = a[2 * mp + 1][n][j];
            o1[j] = x1 * c - x2 * sn; o2[j] = x1 * sn + x2 * c;
          }
          stg_rm4(stg, tl, 32 * mp + fq * 4, o1, osc); stg_rm4(stg, tl, 32 * mp + 16 + fq * 4, o2, osc);
        } else {
          stg_rm4(stg, tl, 32 * mp + fq * 4, a[2 * mp][n], osc); stg_rm4(stg, tl, 32 * mp + 16 + fq * 4, a[2 * mp + 1][n], osc);
        }
      }
    }
    stg_sync();
    copy_out<8>(stg, (bf16_t*)(ws + WS_QC) + (size_t)(nb - gb) * 1536 + cb, 1536, lane);
    stg_sync();
  }
};

struct EpiUKV {
  char* ws; int gb;
  DI void operator()(f32x4 (&a)[4][2], int cb, int nb, int fr, int fq, char* stgc) const {
    bf16_t* stg = (bf16_t*)stgc;
    const int lane = fr + 16 * fq;
    const int head = cb >> 7;
    int tb, S; seq_of(nb, tb, S);
    const bool isv = (cb & 64) != 0;
#pragma unroll
    for (int n = 0; n < 2; ++n) {
      const int tl = n * 16 + fr;
#pragma unroll
      for (int m = 0; m < 4; ++m) {
        if (!isv) stg_rm4(stg, tl, m * 16 + fq * 4, a[m][n], 1.f);
        else stg_tr4(stg, tl, m * 16 + fq * 4, a[m][n]);
      }
    }
    stg_sync();
    if (!isv) copy_out<8>(stg, (bf16_t*)(ws + WS_KN) + (size_t)(nb - gb) * 1024 + head * 64, 1024, lane);
    else copy_out_t(stg, (bf16_t*)(ws + WS_VT) + (size_t)(tb - gb) * 1024 + (size_t)head * 64 * S + (nb - tb), S, lane);
    stg_sync();
  }
};

struct EpiOut {
  const float* xp; const float* xs; float* out; int layer;
  DI void operator()(f32x4 (&a)[4][2], int cb, int nb, int fr, int fq, char* stgc) const {
    float* stg = (float*)stgc;
    const int lane = fr + 16 * fq;
#pragma unroll
    for (int n = 0; n < 2; ++n) {
      const int tl = n * 16 + fr;
#pragma unroll
      for (int m = 0; m < 4; ++m) *(f32x4*)(stg + tl * 68 + m * 16 + fq * 4) = a[m][n];
    }
    stg_sync();
    const float* res = layer == 0 ? (nb < 32768 ? xp + (size_t)nb * 1024 : xs + (size_t)(nb - 32768) * 1024) : out + (size_t)nb * 1024;
    float* dst = out + (size_t)nb * 1024;
#pragma unroll
    for (int j = 0; j < 8; ++j) {
      const int row = (lane >> 4) + 4 * j, c4 = (lane & 15) * 4;
      float4 v = *(const float4*)(stg + row * 68 + c4);
      const float4 rv = *(const float4*)(res + (size_t)row * 1024 + cb + c4);
      v.x += rv.x; v.y += rv.y; v.z += rv.z; v.w += rv.w;
      *(float4*)(dst + (size_t)row * 1024 + cb + c4) = v;
    }
    stg_sync();
  }
};

#define MFMA16(a, b, c) __builtin_amdgcn_mfma_f32_16x16x32_bf16((a), (b), (c), 0, 0, 0)
template <int MODE>
DI void attn_item(const bf16_t* __restrict__ Q, int ldq, const bf16_t* __restrict__ Kp, int ldk, const bf16_t* __restrict__ Kr,
                  const bf16_t* __restrict__ VT, int S, int tile0, int ntiles, bf16_t* __restrict__ G,
                  const float* __restrict__ rpb_h, int R0, int rows, char* smem) {
  constexpr int DQK = MODE == 2 ? 96 : 64;
  constexpr int NK2 = DQK / 32;
  constexpr int KLD = MODE == 2 ? 112 : 80;
  constexpr int VLD = 80;
  constexpr int NKC = MODE == 2 ? 2 : 1;
  constexpr int KBYTES = 64 * 112 * 2;
  constexpr int STAGE = KBYTES + 64 * VLD * 2;
  int tid = threadIdx.x;
  asm volatile("" : "+v"(tid));
  const int lane = tid & 63, w = tid >> 6, i16 = lane & 15, quad = lane >> 4;

  bf16x8 qf[2][NK2];
#pragma unroll
  for (int qb = 0; qb < 2; ++qb)
#pragma unroll
    for (int ks = 0; ks < NK2; ++ks) qf[qb][ks] = *(const bf16x8*)(Q + (size_t)(32 * w + 16 * qb + i16) * ldq + 32 * ks + 8 * quad);
  int rw = 0, rs = 0, qc0 = 0, cs0 = 0, cs1 = 0;
  if (MODE == 0) {
    rw = R0 + (w >> 1);
    rs = min(max(rw - 4, 0), rows - 8);
    qc0 = 32 * (w & 1) + i16;
    cs0 = min(max(qc0 - 8, 0), 48);
    cs1 = min(max(qc0 + 16 - 8, 0), 48);
  }
  f32x4 O[4][2];
#pragma unroll
  for (int db = 0; db < 4; ++db)
#pragma unroll
    for (int qb = 0; qb < 2; ++qb) { O[db][qb][0] = 0.f; O[db][qb][1] = 0.f; O[db][qb][2] = 0.f; O[db][qb][3] = 0.f; }
  float l0 = 0.f, l1 = 0.f, m0 = 0.f, m1 = 0.f;
  bool first = true, mzero = true;

  const bf16_t* kp[NKC]; const bf16_t* vp;
  int krow[NKC], kcol[NKC]; long kstep[NKC];
#pragma unroll
  for (int i = 0; i < NKC; ++i) {
    const int c = i == 0 ? tid : 512 + (tid & 255);
    if (MODE == 2) {
      const int row = c / 12, kc = c - 12 * row;
      krow[i] = row; kcol[i] = kc * 8;
      kp[i] = kc < 8 ? Kp + (size_t)(tile0 * 64 + row) * ldk + kc * 8 : Kr + (size_t)(tile0 * 64 + row) * 672 + (kc - 8) * 8;
      kstep[i] = kc < 8 ? (long)64 * ldk : (long)64 * 672;
    } else {
      const int row = c >> 3, kc = c & 7;
      krow[i] = row; kcol[i] = kc * 8;
      kp[i] = Kp + (size_t)(tile0 * 64 + row) * ldk + kc * 8;
      kstep[i] = (long)64 * ldk;
    }
  }
  const int vd = tid >> 3, vkc = tid & 7;
  vp = VT + (size_t)vd * S + tile0 * 64 + vkc * 8;
  const int vc4 = vkc & 3;
  const int vcol = 32 * (vkc >> 2) + (vc4 < 2 ? 16 * vc4 : 16 * (vc4 - 2) + 4);

  u32x4 kregA[NKC], vregA[1], kregB[NKC], vregB[1];
  auto prefetch = [&](u32x4 (&kreg)[NKC], u32x4 (&vreg)[1], bool adv) {
#pragma unroll
    for (int i = 0; i < NKC; ++i) { kreg[i] = *(const u32x4*)kp[i]; kp[i] += adv ? kstep[i] : 0; }
    vreg[0] = *(const u32x4*)vp; vp += adv ? 64 : 0;
  };
  auto stage_write = [&](char* st, u32x4 (&kreg)[NKC], u32x4 (&vreg)[1]) {
    bf16_t(*wK)[KLD] = (bf16_t(*)[KLD])st;
    bf16_t(*wV)[VLD] = (bf16_t(*)[VLD])(st + KBYTES);
#pragma unroll
    for (int i = 0; i < NKC; ++i) *(u32x4*)&wK[krow[i]][kcol[i]] = kreg[i];
    uint2 lo; lo.x = vreg[0].x; lo.y = vreg[0].y;
    uint2 hi; hi.x = vreg[0].z; hi.y = vreg[0].w;
    *(uint2*)&wV[vd][vcol] = lo;
    *(uint2*)&wV[vd][vcol + 8] = hi;
  };
  __syncthreads();
  prefetch(kregA, vregA, ntiles > 1);
  stage_write(smem, kregA, vregA);
  prefetch(kregB, vregB, ntiles > 2);
  __syncthreads();
  auto compute = [&](int tile, const char* st) {
    if (MODE != 0 || (tile >= rs && tile < rs + 8)) {
      const bf16_t(*sK)[KLD] = (const bf16_t(*)[KLD])st;
      const bf16_t(*sV)[VLD] = (const bf16_t(*)[VLD])(st + KBYTES);
      f32x4 s[4][2];
#pragma unroll
      for (int kb = 0; kb < 4; ++kb)
#pragma unroll
        for (int qb = 0; qb < 2; ++qb) { s[kb][qb][0] = 0.f; s[kb][qb][1] = 0.f; s[kb][qb][2] = 0.f; s[kb][qb][3] = 0.f; }
#pragma unroll
      for (int ks = 0; ks < NK2; ++ks)
#pragma unroll
        for (int kb = 0; kb < 4; ++kb) {
          const bf16x8 a = *(const bf16x8*)&sK[16 * kb + i16][32 * ks + 8 * quad];
          s[kb][0] = MFMA16(a, qf[0][ks], s[kb][0]);
          s[kb][1] = MFMA16(a, qf[1][ks], s[kb][1]);
        }
      bf16x8 va[2][4];
#pragma unroll
      for (int s2 = 0; s2 < 2; ++s2)
#pragma unroll
        for (int db = 0; db < 4; ++db) va[s2][db] = *(const bf16x8*)&sV[16 * db + i16][32 * s2 + 8 * quad];
      if (MODE == 0) {
        int mb0 = 4 * quad - cs0, mb1 = 4 * quad - cs1;
        asm volatile("" : "+v"(mb0), "+v"(mb1));
        const float* bp0 = rpb_h + (tile - rw + 7) * 128 + (4 * quad - qc0 + 63);
        const float* bp1 = bp0 - 16;
#pragma unroll
        for (int kb = 0; kb < 4; ++kb)
#pragma unroll
          for (int j = 0; j < 4; ++j) {
            const int ci = 16 * kb + j;
            const float b0 = bp0[ci], b1 = bp1[ci];
            s[kb][0][j] = ((unsigned)(mb0 + ci) < 16u) ? s[kb][0][j] + b0 : -1e30f;
            s[kb][1][j] = ((unsigned)(mb1 + ci) < 16u) ? s[kb][1][j] + b1 : -1e30f;
          }
      }
      bf16x8 pf[2][2]; float ps0, ps1;
      auto expsum = [&](float mm0, float mm1) {
        float a0 = 0.f, a1 = 0.f;
        u32x4 u00, u01, u10, u11;
#define EPQ(dlo, dhi, kb, qb, mm, acc_, OP) { const float e0 = fexp2(s[kb][qb][0] - mm), e1 = fexp2(s[kb][qb][1] - mm), e2 = fexp2(s[kb][qb][2] - mm), e3 = fexp2(s[kb][qb][3] - mm); \
          acc_ = (((acc_ OP e0) OP e1) OP e2) OP e3; dlo = pk2(e0, e1); dhi = pk2(e2, e3); }
        EPQ(u00.x, u00.y, 0, 0, mm0, a0, +) EPQ(u00.z, u00.w, 1, 0, mm0, a0, +) EPQ(u10.x, u10.y, 2, 0, mm0, a0, +) EPQ(u10.z, u10.w, 3, 0, mm0, a0, +)
        EPQ(u01.x, u01.y, 0, 1, mm1, a1, -) EPQ(u01.z, u01.w, 1, 1, mm1, a1, -) EPQ(u11.x, u11.y, 2, 1, mm1, a1, -) EPQ(u11.z, u11.w, 3, 1, mm1, a1, -)
#undef EPQ
        a1 = -a1;
        pf[0][0] = __builtin_bit_cast(bf16x8, u00); pf[0][1] = __builtin_bit_cast(bf16x8, u01);
        pf[1][0] = __builtin_bit_cast(bf16x8, u10); pf[1][1] = __builtin_bit_cast(bf16x8, u11);
        ps0 = a0; ps1 = a1;
      };
      if (mzero) expsum(0.f, 0.f); else expsum(m0, m1);
      if (__any((ps0 > 1.15e18f) || (ps1 > 1.15e18f) || (first && (ps0 < 8.7e-19f || ps1 < 8.7e-19f)))) {
        float t0 = s[0][0][0], t1 = s[0][1][0];
#pragma unroll
        for (int kb = 0; kb < 4; ++kb)
#pragma unroll
          for (int j = 0; j < 4; ++j) { t0 = fmaxf(t0, s[kb][0][j]); t1 = fmaxf(t1, s[kb][1][j]); }
        t0 = fmaxf(t0, __shfl_xor(t0, 16)); t0 = fmaxf(t0, __shfl_xor(t0, 32));
        t1 = fmaxf(t1, __shfl_xor(t1, 16)); t1 = fmaxf(t1, __shfl_xor(t1, 32));
        const float n0 = first ? t0 : fmaxf(m0, t0), n1 = first ? t1 : fmaxf(m1, t1);
        const float al0 = first ? 1.f : fexp2(m0 - n0), al1 = first ? 1.f : fexp2(m1 - n1);
        m0 = n0; m1 = n1; mzero = false;
        l0 *= al0; l1 *= al1;
#pragma unroll
        for (int db = 0; db < 4; ++db)
#pragma unroll
          for (int j = 0; j < 4; ++j) { O[db][0][j] *= al0; O[db][1][j] *= al1; }
        expsum(m0, m1);
      }
      first = false;
      l0 += ps0; l1 += ps1;
#pragma unroll
      for (int s2 = 0; s2 < 2; ++s2)
#pragma unroll
        for (int db = 0; db < 4; ++db) {
          O[db][0] = MFMA16(va[s2][db], pf[s2][0], O[db][0]);
          O[db][1] = MFMA16(va[s2][db], pf[s2][1], O[db][1]);
        }
    }
  };
  for (int tt = 0; tt < ntiles; tt += 2) {
    prefetch(kregA, vregA, tt + 3 < ntiles);
    __builtin_amdgcn_sched_barrier(0);
    compute(tile0 + tt, smem);
    stage_write(smem + STAGE, kregB, vregB);
    __syncthreads();
    if (tt + 1 < ntiles) {
      prefetch(kregB, vregB, tt + 4 < ntiles);
      __builtin_amdgcn_sched_barrier(0);
      compute(tile0 + tt + 1, smem + STAGE);
      stage_write(smem, kregA, vregA);
      __syncthreads();
    }
  }
  l0 += __shfl_xor(l0, 16); l0 += __shfl_xor(l0, 32);
  l1 += __shfl_xor(l1, 16); l1 += __shfl_xor(l1, 32);
  const float il0 = 1.f / l0, il1 = 1.f / l1;
#pragma unroll
  for (int qb = 0; qb < 2; ++qb) {
    const float il = qb == 0 ? il0 : il1;
    bf16_t* gp = G + (size_t)(32 * w + 16 * qb + i16) * 1024 + 4 * quad;
#pragma unroll
    for (int db = 0; db < 4; ++db) {
      bf16_t* p = gp + 16 * db;
      const uint2 gv = *(const uint2*)p;
      store4(p, O[db][qb][0] * il * bflo(gv.x), O[db][qb][1] * il * bfhi(gv.x), O[db][qb][2] * il * bflo(gv.y), O[db][qb][3] * il * bfhi(gv.y));
    }
  }
}

__global__ void __launch_bounds__(512) mega(Params p) {
  cg::grid_group grid = cg::this_grid();
  __shared__ __attribute__((aligned(16))) char smem[147456];
  const int nw = gridDim.x * 8;
#define IDS() int tid = threadIdx.x; asm volatile("" : "+v"(tid)); const int lane = tid & 63, wave = tid >> 6, gw = blockIdx.x * 8 + wave; (void)lane; (void)wave; (void)gw;
  char* ws = p.ws;
  const int vb = (gridDim.x & 7) == 0 ? (int)(blockIdx.x & 7) * (int)(gridDim.x >> 3) + (int)(blockIdx.x >> 3) : (int)blockIdx.x;

  PH(0) {
    IDS()
    for (int it = blockIdx.x; it < 4080; it += gridDim.x) {
      int i = it;
      float* tile = (float*)smem;
      if (i < 1664) { transpose_tile(p.w_in_e, 3328, (i / 104) * 64, (i % 104) * 32, (bf16_t*)(ws + WS_WT0), 1024, (i % 104) * 32, tile); continue; }
      i -= 1664;
      if (i < 512) { transpose_tile(p.w_out_e, 1024, (i / 32) * 64, (i % 32) * 32, (bf16_t*)(ws + WS_WTO0), 1024, (i % 32) * 32, tile); continue; }
      i -= 512;
      if (i < 848) { const int n0 = (i % 53) * 32; transpose_tile(p.w_in_o, 1696, (i / 53) * 64, n0, (bf16_t*)(ws + WS_WT1), 1024, n0 < 672 ? n0 : n0 + 96, tile); continue; }
      i -= 848;
      if (i < 288) { transpose_tile(p.w_uq, 1536, (i / 48) * 64, (i % 48) * 32, (bf16_t*)(ws + WS_WTUQ), 384, (i % 48) * 32, tile); continue; }
      i -= 288;
      if (i < 256) { transpose_tile(p.w_ukv, 2048, (i / 64) * 64, (i % 64) * 32, (bf16_t*)(ws + WS_WTUKV), 256, (i % 64) * 32, tile); continue; }
      i -= 256;
      transpose_tile(p.w_out_o, 1024, (i / 32) * 64, (i % 32) * 32, (bf16_t*)(ws + WS_WTO1), 1024, (i % 32) * 32, tile);
    }
    for (int i = blockIdx.x * 512 + tid; i < 96 * 1024 / 8; i += gridDim.x * 512) {
      uint4 z; z.x = z.y = z.z = z.w = 0u;
      *(uint4*)((bf16_t*)(ws + WS_WT1) + (size_t)672 * 1024 + (size_t)i * 8) = z;
    }
    for (int i = blockIdx.x * 512 + tid; i < 8 * 15 * 128; i += gridDim.x * 512) {
      const int j = i & 127, hd = i >> 7, off = j - 48;
      ((float*)(ws + WS_TAB))[i] = (off >= 0 && off <= 30) ? p.rpb[hd * 31 + off] * LOG2E : 0.f;
    }
    bf16_t* hb0 = (bf16_t*)p.out;
    for (int t = gw; t < 32768; t += nw)
      rmsnorm_2rows_bf16(p.xp + (size_t)t * 1024, p.xs + (size_t)t * 1024, p.norm_e, hb0 + (size_t)t * 1024, hb0 + (size_t)(t + 32768) * 1024, lane);
  }
  grid.sync();

  PH(1) {
    Epi0 epi{ws, p.qn, p.kn};
    for (int tile = vb; tile < 256 * 13; tile += gridDim.x)
      gemm_tile((const bf16_t*)p.out, 1024, (const bf16_t*)(ws + WS_WT0), 1024, (tile / 13) * 256, (tile % 13) * 256, smem, epi);
  }
  grid.sync();

  PH(2) for (int item = vb; item < 4096; item += gridDim.x) {
    if (item < 2048) {
      int seqtb, S, head, qb;
      if (item < 1024) { const int sq = item >> 9; head = (item >> 6) & 7; qb = item & 63; S = 16384; seqtb = 32768 + sq * 16384; }
      else { const int it = item - 1024; const int sq = it >> 7; head = (it >> 4) & 7; qb = it & 15; S = 4096; seqtb = sq * 4096; }
      const int kvh = head >> 2;
      attn_item<1>((const bf16_t*)(ws + WS_QB) + (size_t)(seqtb + qb * 256) * 512 + head * 64, 512,
                   (const bf16_t*)(ws + WS_KB) + (size_t)seqtb * 128 + kvh * 64, 128, nullptr,
                   (const bf16_t*)(ws + WS_VBT) + (size_t)seqtb * 128 + (size_t)kvh * 64 * S, S, 0, S / 64,
                   (bf16_t*)(ws + WS_G0) + (size_t)(seqtb + qb * 256) * 1024 + 512 + head * 64, nullptr, 0, 0, smem);
    } else {
      const int it = item - 2048;
      const int rq = it >> 3, head = it & 7;
      const int q0 = rq * 256;
      int tb, S; seq_of(q0, tb, S);
      const int rows = S >> 6, R0 = (q0 - tb) >> 6;
      const int rsA = min(max(R0 - 4, 0), rows - 8), rsB = min(max(R0 + 3 - 4, 0), rows - 8);
      attn_item<0>((const bf16_t*)(ws + WS_QA) + (size_t)q0 * 512 + head * 64, 512,
                   (const bf16_t*)(ws + WS_KA) + (size_t)tb * 512 + head * 64, 512, nullptr,
                   (const bf16_t*)(ws + WS_VAT) + (size_t)tb * 512 + (size_t)head * 64 * S, S, rsA, rsB + 8 - rsA,
                   (bf16_t*)(ws + WS_G0) + (size_t)q0 * 1024 + head * 64, (const float*)(ws + WS_TAB) + head * 15 * 128, R0, rows, smem);
    }
  }
  grid.sync();

  PH(3) {
    EpiOut epi{p.xp, p.xs, p.out, 0};
    for (int tile = vb; tile < 256 * 4; tile += gridDim.x)
      gemm_tile((const bf16_t*)(ws + WS_G0), 1024, (const bf16_t*)(ws + WS_WTO0), 1024, (tile >> 2) * 256, (tile & 3) * 256, smem, epi);
  }
  grid.sync();

  PH(4) { IDS() for (int t = gw; t < 32768; t += nw)
    rmsnorm_2rows_bf16(p.out + (size_t)t * 1024, p.out + (size_t)(t + 32768) * 1024, p.norm_o, (bf16_t*)(ws + WS_HB1) + (size_t)t * 1024, (bf16_t*)(ws + WS_HB1) + (size_t)(t + 32768) * 1024, lane);
  }
  grid.sync();

  PH(5) {
    Epi1 epi{ws};
    for (int tile = vb; tile < 256 * 7; tile += gridDim.x)
      gemm_tile((const bf16_t*)(ws + WS_HB1), 1024, (const bf16_t*)(ws + WS_WT1), 1024, (tile / 7) * 256, (tile % 7) * 256, smem, epi);
  }
  grid.sync();

  PH(6) { IDS() for (int t = gw; t < 65536; t += nw) {
    bf16_t* row = (bf16_t*)(ws + WS_LAT) + (size_t)t * 672;
    unsigned cq[3], ckv[2];
    float s1 = 0.f, s2 = 0.f;
#pragma unroll
    for (int j = 0; j < 3; ++j) { cq[j] = *(const unsigned*)(row + 2 * lane + 128 * j); const float a = bflo(cq[j]), b = bfhi(cq[j]); s1 += a * a + b * b; }
#pragma unroll
    for (int j = 0; j < 2; ++j) { ckv[j] = *(const unsigned*)(row + 384 + 2 * lane + 128 * j); const float a = bflo(ckv[j]), b = bfhi(ckv[j]); s2 += a * a + b * b; }
#pragma unroll
    for (int o = 32; o > 0; o >>= 1) { s1 += __shfl_xor(s1, o); s2 += __shfl_xor(s2, o); }
    const float r1 = rsqrtf(s1 * (1.f / 384.f) + 1e-6f), r2 = rsqrtf(s2 * (1.f / 256.f) + 1e-6f);
#pragma unroll
    for (int j = 0; j < 3; ++j) { const int c = 2 * lane + 128 * j; *(unsigned*)(row + c) = pk2(bflo(cq[j]) * r1 * p.qlat_g[c], bfhi(cq[j]) * r1 * p.qlat_g[c + 1]); }
#pragma unroll
    for (int j = 0; j < 2; ++j) { const int c = 2 * lane + 128 * j; *(unsigned*)(row + 384 + c) = pk2(bflo(ckv[j]) * r2 * p.kvlat_g[c], bfhi(ckv[j]) * r2 * p.kvlat_g[c + 1]); }
    if (lane < 16) {
      int tb, S; seq_of(t, tb, S);
      const int s = t - tb;
      const float x1 = bflo((unsigned)row[640 + lane]), x2 = bflo((unsigned)row[656 + lane]);
      const float inv = fexp2(-(float)(lane & 7) * (LOG2_THETA / 8.f));
      const float ang = (lane < 8 ? (float)(s >> 6) : (float)(s & 63)) * inv;
      const float c = __cosf(ang), sn = __sinf(ang);
      row[640 + lane] = (bf16_t)(pk2(x1 * c - x2 * sn, 0.f) & 0xffffu);
      row[656 + lane] = (bf16_t)(pk2(x1 * sn + x2 * c, 0.f) & 0xffffu);
    }
  } }
  grid.sync();

#pragma unroll 1
  for (int g = 0; g < 2; ++g) {
    const int gb = g * 32768;
    PH(7) {
      EpiUQ eq{ws, gb};
      EpiUKV ekv{ws, gb};
      for (int tile = vb; tile < 128 * 14; tile += gridDim.x) {
        const int tt = tile / 14, ct = tile % 14;
        if (ct < 6) gemm_tile((const bf16_t*)(ws + WS_LAT), 672, (const bf16_t*)(ws + WS_WTUQ), 384, gb + tt * 256, ct * 256, smem, eq);
        else gemm_tile((const bf16_t*)(ws + WS_LAT) + 384, 672, (const bf16_t*)(ws + WS_WTUKV), 256, gb + tt * 256, (ct - 6) * 256, smem, ekv);
      }
    }
    grid.sync();
    PH(8) for (int item = vb; item < 2048; item += gridDim.x) {
      int seqtb, S, head, qb;
      if (g == 0) { const int sq = item >> 8; head = (item >> 4) & 15; qb = item & 15; S = 4096; seqtb = sq * 4096; }
      else { const int sq = item >> 10; head = (item >> 6) & 15; qb = item & 63; S = 16384; seqtb = 32768 + sq * 16384; }
      attn_item<2>((const bf16_t*)(ws + WS_QC) + (size_t)(seqtb - gb + qb * 256) * 1536 + head * 96, 1536,
                   (const bf16_t*)(ws + WS_KN) + (size_t)(seqtb - gb) * 1024 + head * 64, 1024,
                   (const bf16_t*)(ws + WS_LAT) + (size_t)seqtb * 672 + 640,
                   (const bf16_t*)(ws + WS_VT) + (size_t)(seqtb - gb) * 1024 + (size_t)head * 64 * S, S, 0, S / 64,
                   (bf16_t*)(ws + WS_G1) + (size_t)(seqtb + qb * 256) * 1024 + head * 64, nullptr, 0, 0, smem);
    }
    grid.sync();
  }

  PH(9) {
    EpiOut epi{p.xp, p.xs, p.out, 1};
    for (int tile = vb; tile < 256 * 4; tile += gridDim.x)
      gemm_tile((const bf16_t*)(ws + WS_G1), 1024, (const bf16_t*)(ws + WS_WTO1), 1024, (tile >> 2) * 256, (tile & 3) * 256, smem, epi);
  }
  grid.sync();

  PH(10) { IDS() for (int t = gw; t < 32768; t += nw)
    rmsnorm_2rows_f32(p.out + (size_t)t * 1024, p.out + (size_t)(t + 32768) * 1024, p.norm_f, lane);
  }
}

extern "C" void kernel_launch(void* const* d_in, const int* in_sizes, int n_in,
                              void* d_out, int out_size, void* d_ws, size_t ws_size,
                              hipStream_t stream) {
  static int grid_blocks = 0;
  if (!grid_blocks) {
    int dev = 0, cus = 0, per_cu = 0;
    (void)hipGetDevice(&dev);
    (void)hipDeviceGetAttribute(&cus, hipDeviceAttributeMultiprocessorCount, dev);
    (void)hipOccupancyMaxActiveBlocksPerMultiprocessor(&per_cu, mega, 512, 0);
    per_cu = 1;
    grid_blocks = cus * per_cu;
  }
  if (ws_size < WS_NEED) { fprintf(stderr, "workspace too small: %zu\n", ws_size); return; }
  Params p{};
  p.xp = (const float*)d_in[0]; p.xs = (const float*)d_in[1];
  p.norm_e = (const float*)d_in[2]; p.w_in_e = (const float*)d_in[3]; p.rpb = (const float*)d_in[4];
  p.qn = (const float*)d_in[5]; p.kn = (const float*)d_in[6]; p.w_out_e = (const float*)d_in[7];
  p.norm_o = (const float*)d_in[8]; p.w_in_o = (const float*)d_in[9]; p.qlat_g = (const float*)d_in[10];
  p.kvlat_g = (const float*)d_in[11]; p.w_uq = (const float*)d_in[12]; p.w_ukv = (const float*)d_in[13];
  p.w_out_o = (const float*)d_in[14]; p.norm_f = (const float*)d_in[15];
  p.out = (float*)d_out; p.ws = (char*)d_ws;
  void* args[] = {&p};
  hipError_t e = hipLaunchCooperativeKernel((void*)mega, dim3(grid_blocks), dim3(512), args, 0, stream);
  if (e != hipSuccess) fprintf(stderr, "cooperative launch failed: %s (grid %d)\n", hipGetErrorString(e), grid_blocks);
}
```

```cpp
#include <hip/hip_runtime.h>
#include <hip/hip_cooperative_groups.h>
#include <cstdio>
namespace cg = cooperative_groups;

typedef unsigned short bf16_t;
using bf16x8 = __attribute__((ext_vector_type(8))) short;
using f32x16 = __attribute__((ext_vector_type(16))) float;
typedef __bf16 bf2_t __attribute__((ext_vector_type(2)));
typedef float f2_t __attribute__((ext_vector_type(2)));
typedef unsigned u32x4 __attribute__((ext_vector_type(4)));
#define DI __device__ __forceinline__
#define MFMA(a, b, c) __builtin_amdgcn_mfma_f32_32x32x16_bf16((a), (b), (c), 0, 0, 0)

#ifndef PHASE_MASK
#define PHASE_MASK 0xFFFF
#endif
#define PH(n) if ((PHASE_MASK >> (n)) & 1)
static constexpr size_t MiB = 1ull << 20;
static constexpr float LOG2E = 1.4426950408889634f;
static constexpr float LOG2_THETA = 13.287712379549449f;

DI unsigned pk2(float a, float b) { f2_t v = {a, b}; bf2_t o = __builtin_convertvector(v, bf2_t); return __builtin_bit_cast(unsigned, o); }
DI float bflo(unsigned u) { return __uint_as_float(u << 16); }
DI float bfhi(unsigned u) { return __uint_as_float(u & 0xffff0000u); }
DI float fexp2(float x) { return __builtin_amdgcn_exp2f(x); }
DI int crow(int i, int h) { return (i & 3) + 8 * (i >> 2) + 4 * h; }
DI float silu(float x) { return x / (1.f + __expf(-x)); }

struct Params {
  const float* xp; const float* xs;
  const float* norm_e; const float* w_in_e; const float* rpb; const float* qn; const float* kn; const float* w_out_e;
  const float* norm_o; const float* w_in_o; const float* qlat_g; const float* kvlat_g; const float* w_uq; const float* w_ukv;
  const float* w_out_o; const float* norm_f;
  float* out; char* ws;
};

#define WS_WT0   (0 * MiB)
#define WS_WTO0  (7 * MiB)
#define WS_WT1   (9 * MiB)
#define WS_WTUQ  (13 * MiB)
#define WS_WTUKV (15 * MiB)
#define WS_WTO1  (16 * MiB)
#define WS_TAB   (20 * MiB)
#define WS_QA    (32 * MiB)
#define WS_KA    (96 * MiB)
#define WS_VAT   (160 * MiB)
#define WS_QB    (224 * MiB)
#define WS_KB    (288 * MiB)
#define WS_VBT   (304 * MiB)
#define WS_G0    (320 * MiB)
#define WS_LAT   (32 * MiB)
#define WS_G1    (128 * MiB)
#define WS_HB1   (256 * MiB)
#define WS_QC    (256 * MiB)
#define WS_KN    (352 * MiB)
#define WS_VT    (416 * MiB)
#define WS_NEED  (480 * MiB)

DI void seq_of(int t, int& tb, int& S) {
  if (t < 32768) { S = 4096; tb = t & ~4095; } else { S = 16384; tb = 32768 + ((t - 32768) & ~16383); }
}

DI void store4(bf16_t* dst, float a, float b, float c, float d) {
  uint2 v; v.x = pk2(a, b); v.y = pk2(c, d); *(uint2*)dst = v;
}

DI void transpose_tile(const float* __restrict__ W, int N, int k0, int n0, bf16_t* __restrict__ WT, int K, int nrow_out, float* tile) {
  const int tid = threadIdx.x;
  const int nn = tid & 31, kq = (tid >> 5) & 7;
  if (tid < 256) {
#pragma unroll
    for (int j = 0; j < 8; ++j) { int kk = kq + 8 * j; tile[kk * 33 + nn] = W[(size_t)(k0 + kk) * N + n0 + nn]; }
  }
  __syncthreads();
  if (tid < 256) {
    const int nn2 = tid >> 3, kc = tid & 7;
    float v[8];
#pragma unroll
    for (int j = 0; j < 8; ++j) v[j] = tile[(kc * 8 + j) * 33 + nn2];
    uint4 o; o.x = pk2(v[0], v[1]); o.y = pk2(v[2], v[3]); o.z = pk2(v[4], v[5]); o.w = pk2(v[6], v[7]);
    *(uint4*)(WT + (size_t)(nrow_out + nn2) * K + k0 + kc * 8) = o;
  }
  __syncthreads();
}

DI void rmsnorm_row_bf16(const float* __restrict__ src, const float* __restrict__ g, bf16_t* __restrict__ dst, int lane) {
  float4 v[4]; float ss = 0.f;
#pragma unroll
  for (int i = 0; i < 4; ++i) { v[i] = *(const float4*)(src + i * 256 + lane * 4); ss += v[i].x * v[i].x + v[i].y * v[i].y + v[i].z * v[i].z + v[i].w * v[i].w; }
#pragma unroll
  for (int o = 32; o > 0; o >>= 1) ss += __shfl_xor(ss, o);
  const float rs = rsqrtf(ss * (1.f / 1024.f) + 1e-6f);
#pragma unroll
  for (int i = 0; i < 4; ++i) {
    float4 gg = *(const float4*)(g + i * 256 + lane * 4);
    store4(dst + i * 256 + lane * 4, v[i].x * rs * gg.x, v[i].y * rs * gg.y, v[i].z * rs * gg.z, v[i].w * rs * gg.w);
  }
}

DI void rmsnorm_2rows_bf16(const float* __restrict__ s0, const float* __restrict__ s1, const float* __restrict__ g,
                           bf16_t* __restrict__ d0, bf16_t* __restrict__ d1, int lane) {
  float4 a[4], b[4]; float sa = 0.f, sb = 0.f;
#pragma unroll
  for (int i = 0; i < 4; ++i) { a[i] = *(const float4*)(s0 + i * 256 + lane * 4); b[i] = *(const float4*)(s1 + i * 256 + lane * 4); }
#pragma unroll
  for (int i = 0; i < 4; ++i) {
    sa += a[i].x * a[i].x + a[i].y * a[i].y + a[i].z * a[i].z + a[i].w * a[i].w;
    sb += b[i].x * b[i].x + b[i].y * b[i].y + b[i].z * b[i].z + b[i].w * b[i].w;
  }
#pragma unroll
  for (int o = 32; o > 0; o >>= 1) { sa += __shfl_xor(sa, o); sb += __shfl_xor(sb, o); }
  const float ra = rsqrtf(sa * (1.f / 1024.f) + 1e-6f), rb = rsqrtf(sb * (1.f / 1024.f) + 1e-6f);
#pragma unroll
  for (int i = 0; i < 4; ++i) {
    const float4 gg = *(const float4*)(g + i * 256 + lane * 4);
    store4(d0 + i * 256 + lane * 4, a[i].x * ra * gg.x, a[i].y * ra * gg.y, a[i].z * ra * gg.z, a[i].w * ra * gg.w);
    store4(d1 + i * 256 + lane * 4, b[i].x * rb * gg.x, b[i].y * rb * gg.y, b[i].z * rb * gg.z, b[i].w * rb * gg.w);
  }
}
DI void rmsnorm_2rows_f32(float* __restrict__ d0, float* __restrict__ d1, const float* __restrict__ g, int lane) {
  float4 a[4], b[4]; float sa = 0.f, sb = 0.f;
#pragma unroll
  for (int i = 0; i < 4; ++i) { a[i] = *(const float4*)(d0 + i * 256 + lane * 4); b[i] = *(const float4*)(d1 + i * 256 + lane * 4); }
#pragma unroll
  for (int i = 0; i < 4; ++i) {
    sa += a[i].x * a[i].x + a[i].y * a[i].y + a[i].z * a[i].z + a[i].w * a[i].w;
    sb += b[i].x * b[i].x + b[i].y * b[i].y + b[i].z * b[i].z + b[i].w * b[i].w;
  }
#pragma unroll
  for (int o = 32; o > 0; o >>= 1) { sa += __shfl_xor(sa, o); sb += __shfl_xor(sb, o); }
  const float ra = rsqrtf(sa * (1.f / 1024.f) + 1e-6f), rb = rsqrtf(sb * (1.f / 1024.f) + 1e-6f);
#pragma unroll
  for (int i = 0; i < 4; ++i) {
    const float4 gg = *(const float4*)(g + i * 256 + lane * 4);
    float4 o; o.x = a[i].x * ra * gg.x; o.y = a[i].y * ra * gg.y; o.z = a[i].z * ra * gg.z; o.w = a[i].w * ra * gg.w;
    *(float4*)(d0 + i * 256 + lane * 4) = o;
    o.x = b[i].x * rb * gg.x; o.y = b[i].y * rb * gg.y; o.z = b[i].z * rb * gg.z; o.w = b[i].w * rb * gg.w;
    *(float4*)(d1 + i * 256 + lane * 4) = o;
  }
}

using f32x4 = __attribute__((ext_vector_type(4))) float;
DI int g8_lds_byte(int r, int c) {
  int st = (r >> 4) * 2 + (c >> 5), rr = r & 15, cc = c & 31, ob = rr * 64 + cc * 2;
  return st * 1024 + (ob ^ (((ob >> 9) & 1) << 5));
}
DI void g8_stage_rc(int b, int& R, int& C) {
  int st = b / 1024, sb = b % 1024, swz = sb ^ (((sb >> 9) & 1) << 5);
  R = (st >> 1) * 16 + swz / 64; C = (st & 1) * 32 + (swz % 64) / 2;
}
template <class Epi>
DI void gemm_tile(const bf16_t* __restrict__ Bt, int ldb, const bf16_t* __restrict__ A, int K, int bcol, int brow, char* smem, Epi epi) {
  constexpr int BK = 64, HALF = 128, HT = HALF * BK;
  bf16_t* shm = (bf16_t*)smem;
  const int lda = K;
#define G8_SA(b, h) (shm + ((b) * 2 + (h)) * HT)
#define G8_SB(b, h) (shm + (4 + (b) * 2 + (h)) * HT)
#define G8_STAGE(P, BASE, LD, OFF, br, kt) do { const bf16_t* _gp = (BASE) + ((long)(br) * (LD) + (long)(kt) * BK); \
    __builtin_amdgcn_global_load_lds((const unsigned*)(_gp + OFF##0), (__attribute__((address_space(3))) unsigned*)((char*)(P) + tid * 16), 16, 0, 0); \
    __builtin_amdgcn_global_load_lds((const unsigned*)(_gp + OFF##1), (__attribute__((address_space(3))) unsigned*)((char*)(P) + tid * 16 + 8192), 16, 0, 0); } while (0)
#define G8_LDA(dst, b, h) for (int m = 0; m < 4; ++m) for (int k = 0; k < 2; ++k) \
    dst[m][k] = *reinterpret_cast<const bf16x8*>((char*)G8_SA(b, h) + g8_lds_byte(wr * 64 + m * 16 + fr, k * 32 + fq * 8))
#define G8_LDB(dst, b, h) for (int n = 0; n < 2; ++n) for (int k = 0; k < 2; ++k) \
    dst[n][k] = *reinterpret_cast<const bf16x8*>((char*)G8_SB(b, h) + g8_lds_byte(wc * 32 + n * 16 + fr, k * 32 + fq * 8))
#define G8_MMA(ai, bj, At, Bt_) do { __builtin_amdgcn_s_setprio(1); \
    for (int m = 0; m < 4; ++m) for (int n = 0; n < 2; ++n) for (int k = 0; k < 2; ++k) \
      acc[ai][bj][m][n] = __builtin_amdgcn_mfma_f32_16x16x32_bf16(At[m][k], Bt_[n][k], acc[ai][bj][m][n], 0, 0, 0); \
    __builtin_amdgcn_s_setprio(0); } while (0)
#define G8_WAIT_V(n) asm volatile("s_waitcnt vmcnt(" #n ")" ::: "memory")
#define G8_WAIT_L(n) asm volatile("s_waitcnt lgkmcnt(" #n ")" ::: "memory")
#define G8_BAR __builtin_amdgcn_s_barrier()
#define G8_SCHED __builtin_amdgcn_sched_barrier(0)
  int tid = threadIdx.x;
  asm volatile("" : "+v"(tid));
  const int wid = tid >> 6, lane = tid & 63, wr = wid >> 2, wc = wid & 3, fr = lane & 15, fq = lane >> 4;
  unsigned offA0, offA1, offB0, offB1;
  { int r0, c0, r1, c1; g8_stage_rc(tid * 16, r0, c0); g8_stage_rc(tid * 16 + 8192, r1, c1);
    offA0 = r0 * lda + c0; offA1 = r1 * lda + c1; offB0 = r0 * ldb + c0; offB1 = r1 * ldb + c1; }
  f32x4 acc[2][2][4][2];
#pragma unroll
  for (int a = 0; a < 2; ++a)
#pragma unroll
    for (int b = 0; b < 2; ++b)
#pragma unroll
      for (int m = 0; m < 4; ++m)
#pragma unroll
        for (int n = 0; n < 2; ++n) { acc[a][b][m][n][0] = 0.f; acc[a][b][m][n][1] = 0.f; acc[a][b][m][n][2] = 0.f; acc[a][b][m][n][3] = 0.f; }
  bf16x8 At[4][2], B0[2][2], B1[2][2];
  const int nt = K / BK;
  __syncthreads();
  G8_STAGE(G8_SB(0, 0), Bt, ldb, offB, bcol, 0); G8_STAGE(G8_SA(0, 0), A, lda, offA, brow, 0);
  G8_STAGE(G8_SB(0, 1), Bt, ldb, offB, bcol + HALF, 0); G8_STAGE(G8_SA(0, 1), A, lda, offA, brow + HALF, 0);
  if (wr == 1) G8_BAR;
  G8_WAIT_V(4); G8_BAR;
  G8_STAGE(G8_SB(1, 0), Bt, ldb, offB, bcol, 1); G8_STAGE(G8_SA(1, 0), A, lda, offA, brow, 1); G8_STAGE(G8_SB(1, 1), Bt, ldb, offB, bcol + HALF, 1);
  G8_WAIT_V(6); G8_BAR;
  for (int t = 0; t < nt - 2; t += 2) {
    G8_LDB(B0, 0, 0); G8_SCHED; G8_LDA(At, 0, 0); G8_STAGE(G8_SA(1, 1), A, lda, offA, brow + HALF, t + 1);
    G8_WAIT_L(8); G8_BAR; G8_WAIT_L(0); G8_MMA(0, 0, At, B0); G8_BAR; G8_SCHED;
    G8_LDB(B1, 0, 1); G8_STAGE(G8_SB(0, 0), Bt, ldb, offB, bcol, t + 2);
    G8_BAR; G8_WAIT_L(0); G8_MMA(0, 1, At, B1); G8_BAR;
    G8_LDA(At, 0, 1); G8_STAGE(G8_SA(0, 0), A, lda, offA, brow, t + 2);
    G8_BAR; G8_WAIT_L(0); G8_MMA(1, 0, At, B0); G8_BAR; G8_SCHED;
    G8_STAGE(G8_SB(0, 1), Bt, ldb, offB, bcol + HALF, t + 2);
    G8_WAIT_V(6); G8_BAR; G8_MMA(1, 1, At, B1); G8_BAR;
    G8_LDB(B0, 1, 0); G8_SCHED; G8_LDA(At, 1, 0); G8_STAGE(G8_SA(0, 1), A, lda, offA, brow + HALF, t + 2);
    G8_WAIT_L(8); G8_BAR; G8_WAIT_L(0); G8_MMA(0, 0, At, B0); G8_BAR; G8_SCHED;
    G8_LDB(B1, 1, 1); G8_STAGE(G8_SB(1, 0), Bt, ldb, offB, bcol, t + 3);
    G8_BAR; G8_WAIT_L(0); G8_MMA(0, 1, At, B1); G8_BAR;
    G8_LDA(At, 1, 1); G8_STAGE(G8_SA(1, 0), A, lda, offA, brow, t + 3);
    G8_BAR; G8_WAIT_L(0); G8_MMA(1, 0, At, B0); G8_BAR; G8_SCHED;
    G8_STAGE(G8_SB(1, 1), Bt, ldb, offB, bcol + HALF, t + 3);
    G8_WAIT_V(6); G8_BAR; G8_MMA(1, 1, At, B1); G8_BAR;
  }
  { G8_LDB(B0, 0, 0); G8_LDA(At, 0, 0); G8_STAGE(G8_SA(1, 1), A, lda, offA, brow + HALF, nt - 1);
    G8_BAR; G8_WAIT_L(0); G8_MMA(0, 0, At, B0); G8_BAR;
    G8_LDB(B1, 0, 1); G8_BAR; G8_WAIT_L(0); G8_MMA(0, 1, At, B1); G8_BAR;
    G8_LDA(At, 0, 1); G8_WAIT_V(4); G8_BAR; G8_WAIT_L(0); G8_MMA(1, 0, At, B0); G8_MMA(1, 1, At, B1); G8_BAR; }
  { G8_LDB(B0, 1, 0); G8_LDA(At, 1, 0); G8_WAIT_V(2); G8_BAR; G8_WAIT_L(0); G8_MMA(0, 0, At, B0); G8_BAR;
    G8_LDB(B1, 1, 1); G8_WAIT_V(0); G8_BAR; G8_WAIT_L(0); G8_MMA(0, 1, At, B1); G8_BAR;
    G8_LDA(At, 1, 1); G8_BAR; G8_WAIT_L(0); G8_MMA(1, 0, At, B0); G8_MMA(1, 1, At, B1); G8_BAR; }
  if (wr == 0) G8_BAR;
  __syncthreads();
  char* stg = smem + wid * 8704;
#pragma unroll
  for (int ai = 0; ai < 2; ++ai)
#pragma unroll
    for (int bj = 0; bj < 2; ++bj)
      epi(acc[ai][bj], brow + ai * HALF + wr * 64, bcol + bj * HALF + wc * 32, fr, fq, stg);
}

static constexpr int STG_LD = 72;
static constexpr int STG_T = 40;
DI void stg_sync() { __builtin_amdgcn_fence(__ATOMIC_RELEASE, "wavefront"); __builtin_amdgcn_wave_barrier(); __builtin_amdgcn_fence(__ATOMIC_ACQUIRE, "wavefront"); }
DI void stg_rm4(bf16_t* stg, int tl, int ch, const f32x4& v, float sc) { store4(stg + tl * STG_LD + ch, v[0] * sc, v[1] * sc, v[2] * sc, v[3] * sc); }
DI void stg_tr4(bf16_t* stg, int tl, int ch, const f32x4& v) {
#pragma unroll
  for (int j = 0; j < 4; ++j) stg[(ch + j) * STG_T + tl] = (bf16_t)(pk2(v[j], 0.f) & 0xffffu);
}
template <int NCH>
DI void copy_out(const bf16_t* stg, bf16_t* dst, size_t ld, int lane) {
  constexpr int RPI = 64 / NCH;
#pragma unroll
  for (int j = 0; j < 32 / RPI; ++j) {
    const int row = lane / NCH + RPI * j, ch = lane % NCH;
    *(u32x4*)(dst + (size_t)row * ld + ch * 8) = *(const u32x4*)(stg + row * STG_LD + ch * 8);
  }
}
DI void copy_out_t(const bf16_t* stg, bf16_t* dst, size_t ld, int lane) {
#pragma unroll
  for (int j = 0; j < 4; ++j) {
    const int row = (lane >> 2) + 16 * j, ch = lane & 3;
    *(u32x4*)(dst + (size_t)row * ld + ch * 8) = *(const u32x4*)(stg + row * STG_T + ch * 8);
  }
}

struct Epi0 {
  char* ws; const float* qn; const float* kn;
  DI void operator()(f32x4 (&a)[4][2], int cb, int nb, int fr, int fq, char* stgc) const {
    bf16_t* stg = (bf16_t*)stgc;
    const int lane = fr + 16 * fq;
    int tb, S; seq_of(nb, tb, S);
    const int s0 = nb - tb;
    const bool tr = (cb >= 1024 && cb < 1536) || (cb >= 2176 && cb < 2304);
#pragma unroll
    for (int n = 0; n < 2; ++n) {
      const int tl = n * 16 + fr;
      const int s = s0 + tl;
      if (tr) {
#pragma unroll
        for (int m = 0; m < 4; ++m) stg_tr4(stg, tl, m * 16 + fq * 4, a[m][n]);
      } else if (cb < 1024) {
        const float sc = cb < 512 ? 0.125f * LOG2E : 1.f;
#pragma unroll
        for (int m = 0; m < 4; ++m) stg_rm4(stg, tl, m * 16 + fq * 4, a[m][n], sc);
      } else if (cb < 2176) {
        const bool isq = cb < 2048;
        const float* gsrc = isq ? qn : kn;
        float ss = 0.f;
#pragma unroll
        for (int m = 0; m < 4; ++m)
#pragma unroll
          for (int j = 0; j < 4; ++j) ss += a[m][n][j] * a[m][n][j];
        ss += __shfl_xor(ss, 16); ss += __shfl_xor(ss, 32);
        const float rs = rsqrtf(ss * (1.f / 64.f) + 1e-6f);
        const float frow = (float)(s >> 6), fcol = (float)(s & 63);
        const float osc = isq ? 0.125f * LOG2E : 1.f;
#pragma unroll
        for (int m = 0; m < 2; ++m) {
          f32x4 o1, o2;
#pragma unroll
          for (int j = 0; j < 4; ++j) {
            const int d1 = m * 16 + fq * 4 + j;
            const float x1 = a[m][n][j] * rs * gsrc[d1], x2 = a[m + 2][n][j] * rs * gsrc[d1 + 32];
            const float inv = fexp2(-(float)(d1 & 15) * (LOG2_THETA / 16.f));
            const float ang = (m == 0 ? frow : fcol) * inv;
            const float c = __cosf(ang), sn = __sinf(ang);
            o1[j] = (x1 * c - x2 * sn) * osc; o2[j] = (x1 * sn + x2 * c) * osc;
          }
          stg_rm4(stg, tl, m * 16 + fq * 4, o1, 1.f); stg_rm4(stg, tl, 32 + m * 16 + fq * 4, o2, 1.f);
        }
      } else {
#pragma unroll
        for (int m = 0; m < 4; ++m) {
          f32x4 o;
#pragma unroll
          for (int j = 0; j < 4; ++j) o[j] = silu(a[m][n][j]);
          stg_rm4(stg, tl, m * 16 + fq * 4, o, 1.f);
        }
      }
    }
    stg_sync();
    if (cb < 512) copy_out<8>(stg, (bf16_t*)(ws + WS_QA) + (size_t)nb * 512 + cb, 512, lane);
    else if (cb < 1024) copy_out<8>(stg, (bf16_t*)(ws + WS_KA) + (size_t)nb * 512 + (cb - 512), 512, lane);
    else if (cb < 1536) copy_out_t(stg, (bf16_t*)(ws + WS_VAT) + (size_t)tb * 512 + (size_t)(cb - 1024) * S + s0, S, lane);
    else if (cb < 2048) copy_out<8>(stg, (bf16_t*)(ws + WS_QB) + (size_t)nb * 512 + (cb - 1536), 512, lane);
    else if (cb < 2176) copy_out<8>(stg, (bf16_t*)(ws + WS_KB) + (size_t)nb * 128 + (cb - 2048), 128, lane);
    else if (cb < 2304) copy_out_t(stg, (bf16_t*)(ws + WS_VBT) + (size_t)tb * 128 + (size_t)(cb - 2176) * S + s0, S, lane);
    else copy_out<8>(stg, (bf16_t*)(ws + WS_G0) + (size_t)nb * 1024 + (cb - 2304), 1024, lane);
    stg_sync();
  }
};

struct Epi1 {
  char* ws;
  DI void operator()(f32x4 (&a)[4][2], int cb, int nb, int fr, int fq, char* stgc) const {
    bf16_t* stg = (bf16_t*)stgc;
    const int lane = fr + 16 * fq;
    if (cb >= 672 && cb < 768) return;
#pragma unroll
    for (int n = 0; n < 2; ++n) {
      const int tl = n * 16 + fr;
#pragma unroll
      for (int m = 0; m < 4; ++m) {
        if (cb < 768) stg_rm4(stg, tl, m * 16 + fq * 4, a[m][n], 1.f);
        else {
          f32x4 o;
#pragma unroll
          for (int j = 0; j < 4; ++j) o[j] = silu(a[m][n][j]);
          stg_rm4(stg, tl, m * 16 + fq * 4, o, 1.f);
        }
      }
    }
    stg_sync();
    if (cb == 640) copy_out<4>(stg, (bf16_t*)(ws + WS_LAT) + (size_t)nb * 672 + 640, 672, lane);
    else if (cb < 640) copy_out<8>(stg, (bf16_t*)(ws + WS_LAT) + (size_t)nb * 672 + cb, 672, lane);
    else copy_out<8>(stg, (bf16_t*)(ws + WS_G1) + (size_t)nb * 1024 + (cb - 768), 1024, lane);
    stg_sync();
  }
};

struct EpiUQ {
  char* ws; int gb;
  DI void operator()(f32x4 (&a)[4][2], int cb, int nb, int fr, int fq, char* stgc) const {
    bf16_t* stg = (bf16_t*)stgc;
    const int lane = fr + 16 * fq;
    const float osc = 0.10206207261596577f * LOG2E;
    int tb, S; seq_of(nb, tb, S);
#pragma unroll
    for (int n = 0; n < 2; ++n) {
      const int tl = n * 16 + fr;
      const int s = nb - tb + tl;
      const float frow = (float)(s >> 6), fcol = (float)(s & 63);
#pragma unroll
      for (int mp = 0; mp < 2; ++mp) {
        const int c32 = cb + 32 * mp;
        if ((c32 % 96) == 64) {
          f32x4 o1, o2;
#pragma unroll
          for (int j = 0; j < 4; ++j) {
            const int p = fq * 4 + j;
            const float inv = fexp2(-(float)(p & 7) * (LOG2_THETA / 8.f));
            const float ang = (p < 8 ? frow : fcol) * inv;
            const float c = __cosf(ang), sn = __sinf(ang);
            const float x1 = a[2 * mp][n][j], x2 = a[2 * mp + 1][n][j];
            o1[j] = x1 * c - x2 * sn; o2[j] = x1 * sn + x2 * c;
          }
          stg_rm4(stg, tl, 32 * mp + fq * 4, o1, osc); stg_rm4(stg, tl, 32 * mp + 16 + fq * 4, o2, osc);
        } else {
          stg_rm4(stg, tl, 32 * mp + fq * 4, a[2 * mp][n], osc); stg_rm4(stg, tl, 32 * mp + 16 + fq * 4, a[2 * mp + 1][n], osc);
        }
      }
    }
    stg_sync();
    copy_out<8>(stg, (bf16_t*)(ws + WS_QC) + (size_t)(nb - gb) * 1536 + cb, 1536, lane);
    stg_sync();
  }
};

struct EpiUKV {
  char* ws; int gb;
  DI void operator()(f32x4 (&a)[4][2], int cb, int nb, int fr, int fq, char* stgc) const {
    bf16_t* stg = (bf16_t*)stgc;
    const int lane = fr + 16 * fq;
    const int head = cb >> 7;
    int tb, S; seq_of(nb, tb, S);
    const bool isv = (cb & 64) != 0;
#pragma unroll
    for (int n = 0; n < 2; ++n) {
      const int tl = n * 16 + fr;
#pragma unroll
      for (int m = 0; m < 4; ++m) {
        if (!isv) stg_rm4(stg, tl, m * 16 + fq * 4, a[m][n], 1.f);
        else stg_tr4(stg, tl, m * 16 + fq * 4, a[m][n]);
      }
    }
    stg_sync();
    if (!isv) copy_out<8>(stg, (bf16_t*)(ws + WS_KN) + (size_t)(nb - gb) * 1024 + head * 64, 1024, lane);
    else copy_out_t(stg, (bf16_t*)(ws + WS_VT) + (size_t)(tb - gb) * 1024 + (size_t)head * 64 * S + (nb - tb), S, lane);
    stg_sync();
  }
};

struct EpiOut {
  const float* xp; const float* xs; float* out; int layer;
  DI void operator()(f32x4 (&a)[4][2], int cb, int nb, int fr, int fq, char* stgc) const {
    float* stg = (float*)stgc;
    const int lane = fr + 16 * fq;
#pragma unroll
    for (int n = 0; n < 2; ++n) {
      const int tl = n * 16 + fr;
#pragma unroll
      for (int m = 0; m < 4; ++m) *(f32x4*)(stg + tl * 68 + m * 16 + fq * 4) = a[m][n];
    }
    stg_sync();
    const float* res = layer == 0 ? (nb < 32768 ? xp + (size_t)nb * 1024 : xs + (size_t)(nb - 32768) * 1024) : out + (size_t)nb * 1024;
    float* dst = out + (size_t)nb * 1024;
    const int c4 = (lane & 15) * 4;
    f32x4 rv[8];
#pragma unroll
    for (int j = 0; j < 8; ++j) rv[j] = *(const f32x4*)(res + (size_t)((lane >> 4) + 4 * j) * 1024 + cb + c4);
#pragma unroll
    for (int j = 0; j < 8; ++j) {
      const int row = (lane >> 4) + 4 * j;
      const f32x4 v = *(const f32x4*)(stg + row * 68 + c4) + rv[j];
      *(f32x4*)(dst + (size_t)row * 1024 + cb + c4) = v;
    }
    stg_sync();
  }
};

#define MFMA16(a, b, c) __builtin_amdgcn_mfma_f32_16x16x32_bf16((a), (b), (c), 0, 0, 0)
template <int MODE>
DI void attn_item(const bf16_t* __restrict__ Q, int ldq, const bf16_t* __restrict__ Kp, int ldk, const bf16_t* __restrict__ Kr,
                  const bf16_t* __restrict__ VT, int S, int tile0, int ntiles, bf16_t* __restrict__ G,
                  const float* __restrict__ rpb_h, int R0, int rows, char* smem) {
  constexpr int DQK = MODE == 2 ? 96 : 64;
  constexpr int NK2 = DQK / 32;
  constexpr int KLD = MODE == 2 ? 112 : 80;
  constexpr int VLD = 80;
  constexpr int NKC = MODE == 2 ? 2 : 1;
  constexpr int KBYTES = 64 * 112 * 2;
  constexpr int STAGE = KBYTES + 64 * VLD * 2;
  int tid = threadIdx.x;
  asm volatile("" : "+v"(tid));
  const int lane = tid & 63, w = tid >> 6, i16 = lane & 15, quad = lane >> 4;

  bf16x8 qf[2][NK2];
#pragma unroll
  for (int qb = 0; qb < 2; ++qb)
#pragma unroll
    for (int ks = 0; ks < NK2; ++ks) qf[qb][ks] = *(const bf16x8*)(Q + (size_t)(32 * w + 16 * qb + i16) * ldq + 32 * ks + 8 * quad);
  int rw = 0, rs = 0, qc0 = 0, cs0 = 0, cs1 = 0;
  if (MODE == 0) {
    rw = R0 + (w >> 1);
    rs = min(max(rw - 4, 0), rows - 8);
    qc0 = 32 * (w & 1) + i16;
    cs0 = min(max(qc0 - 8, 0), 48);
    cs1 = min(max(qc0 + 16 - 8, 0), 48);
  }
  f32x4 O[4][2];
#pragma unroll
  for (int db = 0; db < 4; ++db)
#pragma unroll
    for (int qb = 0; qb < 2; ++qb) { O[db][qb][0] = 0.f; O[db][qb][1] = 0.f; O[db][qb][2] = 0.f; O[db][qb][3] = 0.f; }
  float l0 = 0.f, l1 = 0.f, m0 = 0.f, m1 = 0.f;
  bool first = true, mzero = true;

  const bf16_t* kp[NKC]; const bf16_t* vp;
  int krow[NKC], kcol[NKC]; long kstep[NKC];
#pragma unroll
  for (int i = 0; i < NKC; ++i) {
    const int c = i == 0 ? tid : 512 + (tid & 255);
    if (MODE == 2) {
      const int row = c / 12, kc = c - 12 * row;
      krow[i] = row; kcol[i] = kc * 8;
      kp[i] = kc < 8 ? Kp + (size_t)(tile0 * 64 + row) * ldk + kc * 8 : Kr + (size_t)(tile0 * 64 + row) * 672 + (kc - 8) * 8;
      kstep[i] = kc < 8 ? (long)64 * ldk : (long)64 * 672;
    } else {
      const int row = c >> 3, kc = c & 7;
      krow[i] = row; kcol[i] = kc * 8;
      kp[i] = Kp + (size_t)(tile0 * 64 + row) * ldk + kc * 8;
      kstep[i] = (long)64 * ldk;
    }
  }
  const int vd = tid >> 3, vkc = tid & 7;
  vp = VT + (size_t)vd * S + tile0 * 64 + vkc * 8;
  const int vc4 = vkc & 3;
  const int vcol = 32 * (vkc >> 2) + (vc4 < 2 ? 16 * vc4 : 16 * (vc4 - 2) + 4);

  u32x4 kregA[NKC], vregA[1], kregB[NKC], vregB[1];
  auto prefetch = [&](u32x4 (&kreg)[NKC], u32x4 (&vreg)[1], bool adv) {
#pragma unroll
    for (int i = 0; i < NKC; ++i) { kreg[i] = *(const u32x4*)kp[i]; kp[i] += adv ? kstep[i] : 0; }
    vreg[0] = *(const u32x4*)vp; vp += adv ? 64 : 0;
  };
  auto stage_write = [&](char* st, u32x4 (&kreg)[NKC], u32x4 (&vreg)[1]) {
    bf16_t(*wK)[KLD] = (bf16_t(*)[KLD])st;
    bf16_t(*wV)[VLD] = (bf16_t(*)[VLD])(st + KBYTES);
#pragma unroll
    for (int i = 0; i < NKC; ++i) *(u32x4*)&wK[krow[i]][kcol[i]] = kreg[i];
    uint2 lo; lo.x = vreg[0].x; lo.y = vreg[0].y;
    uint2 hi; hi.x = vreg[0].z; hi.y = vreg[0].w;
    *(uint2*)&wV[vd][vcol] = lo;
    *(uint2*)&wV[vd][vcol + 8] = hi;
  };
  __syncthreads();
  prefetch(kregA, vregA, ntiles > 1);
  stage_write(smem, kregA, vregA);
  prefetch(kregB, vregB, ntiles > 2);
  __syncthreads();
  auto compute = [&](int tile, const char* st) {
    if (MODE != 0 || (tile >= rs && tile < rs + 8)) {
      const bf16_t(*sK)[KLD] = (const bf16_t(*)[KLD])st;
      const bf16_t(*sV)[VLD] = (const bf16_t(*)[VLD])(st + KBYTES);
      f32x4 s[4][2];
#pragma unroll
      for (int kb = 0; kb < 4; ++kb)
#pragma unroll
        for (int qb = 0; qb < 2; ++qb) { s[kb][qb][0] = 0.f; s[kb][qb][1] = 0.f; s[kb][qb][2] = 0.f; s[kb][qb][3] = 0.f; }
#pragma unroll
      for (int ks = 0; ks < NK2; ++ks)
#pragma unroll
        for (int kb = 0; kb < 4; ++kb) {
          const bf16x8 a = *(const bf16x8*)&sK[16 * kb + i16][32 * ks + 8 * quad];
          s[kb][0] = MFMA16(a, qf[0][ks], s[kb][0]);
          s[kb][1] = MFMA16(a, qf[1][ks], s[kb][1]);
        }
      bf16x8 va[2][4];
#pragma unroll
      for (int s2 = 0; s2 < 2; ++s2)
#pragma unroll
        for (int db = 0; db < 4; ++db) va[s2][db] = *(const bf16x8*)&sV[16 * db + i16][32 * s2 + 8 * quad];
      if (MODE == 0) {
        int mb0 = 4 * quad - cs0, mb1 = 4 * quad - cs1;
        asm volatile("" : "+v"(mb0), "+v"(mb1));
        const float* bp0 = rpb_h + (tile - rw + 7) * 128 + (4 * quad - qc0 + 63);
        const float* bp1 = bp0 - 16;
#pragma unroll
        for (int kb = 0; kb < 4; ++kb)
#pragma unroll
          for (int j = 0; j < 4; ++j) {
            const int ci = 16 * kb + j;
            const float b0 = bp0[ci], b1 = bp1[ci];
            s[kb][0][j] = ((unsigned)(mb0 + ci) < 16u) ? s[kb][0][j] + b0 : -1e30f;
            s[kb][1][j] = ((unsigned)(mb1 + ci) < 16u) ? s[kb][1][j] + b1 : -1e30f;
          }
      }
      bf16x8 pf[2][2]; float ps0, ps1;
      auto expsum = [&](float mm0, float mm1) {
        float a0 = 0.f, a1 = 0.f;
        u32x4 u00, u01, u10, u11;
#define EPQ(dlo, dhi, kb, qb, mm, acc_, OP) { const float e0 = fexp2(s[kb][qb][0] - mm), e1 = fexp2(s[kb][qb][1] - mm), e2 = fexp2(s[kb][qb][2] - mm), e3 = fexp2(s[kb][qb][3] - mm); \
          acc_ = (((acc_ OP e0) OP e1) OP e2) OP e3; dlo = pk2(e0, e1); dhi = pk2(e2, e3); }
        EPQ(u00.x, u00.y, 0, 0, mm0, a0, +) EPQ(u00.z, u00.w, 1, 0, mm0, a0, +) EPQ(u10.x, u10.y, 2, 0, mm0, a0, +) EPQ(u10.z, u10.w, 3, 0, mm0, a0, +)
        EPQ(u01.x, u01.y, 0, 1, mm1, a1, -) EPQ(u01.z, u01.w, 1, 1, mm1, a1, -) EPQ(u11.x, u11.y, 2, 1, mm1, a1, -) EPQ(u11.z, u11.w, 3, 1, mm1, a1, -)
#undef EPQ
        a1 = -a1;
        pf[0][0] = __builtin_bit_cast(bf16x8, u00); pf[0][1] = __builtin_bit_cast(bf16x8, u01);
        pf[1][0] = __builtin_bit_cast(bf16x8, u10); pf[1][1] = __builtin_bit_cast(bf16x8, u11);
        ps0 = a0; ps1 = a1;
      };
      if (mzero) expsum(0.f, 0.f); else expsum(m0, m1);
      if (__any((ps0 > 1.15e18f) || (ps1 > 1.15e18f) || (first && (ps0 < 8.7e-19f || ps1 < 8.7e-19f)))) {
        float t0 = s[0][0][0], t1 = s[0][1][0];
#pragma unroll
        for (int kb = 0; kb < 4; ++kb)
#pragma unroll
          for (int j = 0; j < 4; ++j) { t0 = fmaxf(t0, s[kb][0][j]); t1 = fmaxf(t1, s[kb][1][j]); }
        t0 = fmaxf(t0, __shfl_xor(t0, 16)); t0 = fmaxf(t0, __shfl_xor(t0, 32));
        t1 = fmaxf(t1, __shfl_xor(t1, 16)); t1 = fmaxf(t1, __shfl_xor(t1, 32));
        const float n0 = first ? t0 : fmaxf(m0, t0), n1 = first ? t1 : fmaxf(m1, t1);
        const float al0 = first ? 1.f : fexp2(m0 - n0), al1 = first ? 1.f : fexp2(m1 - n1);
        m0 = n0; m1 = n1; mzero = false;
        l0 *= al0; l1 *= al1;
#pragma unroll
        for (int db = 0; db < 4; ++db)
#pragma unroll
          for (int j = 0; j < 4; ++j) { O[db][0][j] *= al0; O[db][1][j] *= al1; }
        expsum(m0, m1);
      }
      first = false;
      l0 += ps0; l1 += ps1;
#pragma unroll
      for (int s2 = 0; s2 < 2; ++s2)
#pragma unroll
        for (int db = 0; db < 4; ++db) {
          O[db][0] = MFMA16(va[s2][db], pf[s2][0], O[db][0]);
          O[db][1] = MFMA16(va[s2][db], pf[s2][1], O[db][1]);
        }
    }
  };
  for (int tt = 0; tt < ntiles; tt += 2) {
    prefetch(kregA, vregA, tt + 3 < ntiles);
    __builtin_amdgcn_sched_barrier(0);
    compute(tile0 + tt, smem);
    stage_write(smem + STAGE, kregB, vregB);
    __syncthreads();
    if (tt + 1 < ntiles) {
      prefetch(kregB, vregB, tt + 4 < ntiles);
      __builtin_amdgcn_sched_barrier(0);
      compute(tile0 + tt + 1, smem + STAGE);
      stage_write(smem, kregA, vregA);
      __syncthreads();
    }
  }
  l0 += __shfl_xor(l0, 16); l0 += __shfl_xor(l0, 32);
  l1 += __shfl_xor(l1, 16); l1 += __shfl_xor(l1, 32);
  const float il0 = 1.f / l0, il1 = 1.f / l1;
  typedef unsigned u32x2 __attribute__((ext_vector_type(2)));
  u32x2 gv[2][4];
#pragma unroll
  for (int qb = 0; qb < 2; ++qb)
#pragma unroll
    for (int db = 0; db < 4; ++db) gv[qb][db] = *(const u32x2*)(G + (size_t)(32 * w + 16 * qb + i16) * 1024 + 4 * quad + 16 * db);
#pragma unroll
  for (int qb = 0; qb < 2; ++qb) {
    const float il = qb == 0 ? il0 : il1;
    bf16_t* gp = G + (size_t)(32 * w + 16 * qb + i16) * 1024 + 4 * quad;
#pragma unroll
    for (int db = 0; db < 4; ++db) {
      const u32x2 g_ = gv[qb][db];
      store4(gp + 16 * db, O[db][qb][0] * il * bflo(g_.x), O[db][qb][1] * il * bfhi(g_.x), O[db][qb][2] * il * bflo(g_.y), O[db][qb][3] * il * bfhi(g_.y));
    }
  }
}

__global__ void __launch_bounds__(512) mega(Params p) {
  cg::grid_group grid = cg::this_grid();
  __shared__ __attribute__((aligned(16))) char smem[147456];
  const int nw = gridDim.x * 8;
#define IDS() int tid = threadIdx.x; asm volatile("" : "+v"(tid)); const int lane = tid & 63, wave = tid >> 6, gw = blockIdx.x * 8 + wave; (void)lane; (void)wave; (void)gw;
  char* ws = p.ws;
  const int vb = (gridDim.x & 7) == 0 ? (int)(blockIdx.x & 7) * (int)(gridDim.x >> 3) + (int)(blockIdx.x >> 3) : (int)blockIdx.x;

  PH(0) {
    IDS()
    for (int it = blockIdx.x; it < 4080; it += gridDim.x) {
      int i = it;
      float* tile = (float*)smem;
      if (i < 1664) { transpose_tile(p.w_in_e, 3328, (i / 104) * 64, (i % 104) * 32, (bf16_t*)(ws + WS_WT0), 1024, (i % 104) * 32, tile); continue; }
      i -= 1664;
      if (i < 512) { transpose_tile(p.w_out_e, 1024, (i / 32) * 64, (i % 32) * 32, (bf16_t*)(ws + WS_WTO0), 1024, (i % 32) * 32, tile); continue; }
      i -= 512;
      if (i < 848) { const int n0 = (i % 53) * 32; transpose_tile(p.w_in_o, 1696, (i / 53) * 64, n0, (bf16_t*)(ws + WS_WT1), 1024, n0 < 672 ? n0 : n0 + 96, tile); continue; }
      i -= 848;
      if (i < 288) { transpose_tile(p.w_uq, 1536, (i / 48) * 64, (i % 48) * 32, (bf16_t*)(ws + WS_WTUQ), 384, (i % 48) * 32, tile); continue; }
      i -= 288;
      if (i < 256) { transpose_tile(p.w_ukv, 2048, (i / 64) * 64, (i % 64) * 32, (bf16_t*)(ws + WS_WTUKV), 256, (i % 64) * 32, tile); continue; }
      i -= 256;
      transpose_tile(p.w_out_o, 1024, (i / 32) * 64, (i % 32) * 32, (bf16_t*)(ws + WS_WTO1), 1024, (i % 32) * 32, tile);
    }
    for (int i = blockIdx.x * 512 + tid; i < 96 * 1024 / 8; i += gridDim.x * 512) {
      uint4 z; z.x = z.y = z.z = z.w = 0u;
      *(uint4*)((bf16_t*)(ws + WS_WT1) + (size_t)672 * 1024 + (size_t)i * 8) = z;
    }
    for (int i = blockIdx.x * 512 + tid; i < 8 * 15 * 128; i += gridDim.x * 512) {
      const int j = i & 127, hd = i >> 7, off = j - 48;
      ((float*)(ws + WS_TAB))[i] = (off >= 0 && off <= 30) ? p.rpb[hd * 31 + off] * LOG2E : 0.f;
    }
    bf16_t* hb0 = (bf16_t*)p.out;
    for (int t = gw; t < 32768; t += nw)
      rmsnorm_2rows_bf16(p.xp + (size_t)t * 1024, p.xs + (size_t)t * 1024, p.norm_e, hb0 + (size_t)t * 1024, hb0 + (size_t)(t + 32768) * 1024, lane);
  }
  grid.sync();

  PH(1) {
    Epi0 epi{ws, p.qn, p.kn};
    for (int tile = vb; tile < 256 * 13; tile += gridDim.x)
      gemm_tile((const bf16_t*)p.out, 1024, (const bf16_t*)(ws + WS_WT0), 1024, (tile / 13) * 256, (tile % 13) * 256, smem, epi);
  }
  grid.sync();

  PH(2) for (int item = vb; item < 4096; item += gridDim.x) {
    if (item < 2048) {
      int seqtb, S, head, qb;
      if (item < 1024) { const int sq = item >> 9; head = (item >> 6) & 7; qb = item & 63; S = 16384; seqtb = 32768 + sq * 16384; }
      else { const int it = item - 1024; const int sq = it >> 7; head = (it >> 4) & 7; qb = it & 15; S = 4096; seqtb = sq * 4096; }
      const int kvh = head >> 2;
      attn_item<1>((const bf16_t*)(ws + WS_QB) + (size_t)(seqtb + qb * 256) * 512 + head * 64, 512,
                   (const bf16_t*)(ws + WS_KB) + (size_t)seqtb * 128 + kvh * 64, 128, nullptr,
                   (const bf16_t*)(ws + WS_VBT) + (size_t)seqtb * 128 + (size_t)kvh * 64 * S, S, 0, S / 64,
                   (bf16_t*)(ws + WS_G0) + (size_t)(seqtb + qb * 256) * 1024 + 512 + head * 64, nullptr, 0, 0, smem);
    } else {
      const int it = item - 2048;
      const int rq = it >> 3, head = it & 7;
      const int q0 = rq * 256;
      int tb, S; seq_of(q0, tb, S);
      const int rows = S >> 6, R0 = (q0 - tb) >> 6;
      const int rsA = min(max(R0 - 4, 0), rows - 8), rsB = min(max(R0 + 3 - 4, 0), rows - 8);
      attn_item<0>((const bf16_t*)(ws + WS_QA) + (size_t)q0 * 512 + head * 64, 512,
                   (const bf16_t*)(ws + WS_KA) + (size_t)tb * 512 + head * 64, 512, nullptr,
                   (const bf16_t*)(ws + WS_VAT) + (size_t)tb * 512 + (size_t)head * 64 * S, S, rsA, rsB + 8 - rsA,
                   (bf16_t*)(ws + WS_G0) + (size_t)q0 * 1024 + head * 64, (const float*)(ws + WS_TAB) + head * 15 * 128, R0, rows, smem);
    }
  }
  grid.sync();

  PH(3) {
    EpiOut epi{p.xp, p.xs, p.out, 0};
    for (int tile = vb; tile < 256 * 4; tile += gridDim.x)
      gemm_tile((const bf16_t*)(ws + WS_G0), 1024, (const bf16_t*)(ws + WS_WTO0), 1024, (tile >> 2) * 256, (tile & 3) * 256, smem, epi);
  }
  grid.sync();

  PH(4) { IDS() for (int t = gw; t < 32768; t += nw)
    rmsnorm_2rows_bf16(p.out + (size_t)t * 1024, p.out + (size_t)(t + 32768) * 1024, p.norm_o, (bf16_t*)(ws + WS_HB1) + (size_t)t * 1024, (bf16_t*)(ws + WS_HB1) + (size_t)(t + 32768) * 1024, lane);
  }
  grid.sync();

  PH(5) {
    Epi1 epi{ws};
    for (int tile = vb; tile < 256 * 7; tile += gridDim.x)
      gemm_tile((const bf16_t*)(ws + WS_HB1), 1024, (const bf16_t*)(ws + WS_WT1), 1024, (tile / 7) * 256, (tile % 7) * 256, smem, epi);
  }
  grid.sync();

  PH(6) { IDS() for (int t = gw; t < 65536; t += nw) {
    bf16_t* row = (bf16_t*)(ws + WS_LAT) + (size_t)t * 672;
    unsigned cq[3], ckv[2];
    float s1 = 0.f, s2 = 0.f;
#pragma unroll
    for (int j = 0; j < 3; ++j) { cq[j] = *(const unsigned*)(row + 2 * lane + 128 * j); const float a = bflo(cq[j]), b = bfhi(cq[j]); s1 += a * a + b * b; }
#pragma unroll
    for (int j = 0; j < 2; ++j) { ckv[j] = *(const unsigned*)(row + 384 + 2 * lane + 128 * j); const float a = bflo(ckv[j]), b = bfhi(ckv[j]); s2 += a * a + b * b; }
#pragma unroll
    for (int o = 32; o > 0; o >>= 1) { s1 += __shfl_xor(s1, o); s2 += __shfl_xor(s2, o); }
    const float r1 = rsqrtf(s1 * (1.f / 384.f) + 1e-6f), r2 = rsqrtf(s2 * (1.f / 256.f) + 1e-6f);
#pragma unroll
    for (int j = 0; j < 3; ++j) { const int c = 2 * lane + 128 * j; *(unsigned*)(row + c) = pk2(bflo(cq[j]) * r1 * p.qlat_g[c], bfhi(cq[j]) * r1 * p.qlat_g[c + 1]); }
#pragma unroll
    for (int j = 0; j < 2; ++j) { const int c = 2 * lane + 128 * j; *(unsigned*)(row + 384 + c) = pk2(bflo(ckv[j]) * r2 * p.kvlat_g[c], bfhi(ckv[j]) * r2 * p.kvlat_g[c + 1]); }
    if (lane < 16) {
      int tb, S; seq_of(t, tb, S);
      const int s = t - tb;
      const float x1 = bflo((unsigned)row[640 + lane]), x2 = bflo((unsigned)row[656 + lane]);
      const float inv = fexp2(-(float)(lane & 7) * (LOG2_THETA / 8.f));
      const float ang = (lane < 8 ? (float)(s >> 6) : (float)(s & 63)) * inv;
      const float c = __cosf(ang), sn = __sinf(ang);
      row[640 + lane] = (bf16_t)(pk2(x1 * c - x2 * sn, 0.f) & 0xffffu);
      row[656 + lane] = (bf16_t)(pk2(x1 * sn + x2 * c, 0.f) & 0xffffu);
    }
  } }
  grid.sync();

#pragma unroll 1
  for (int g = 0; g < 2; ++g) {
    const int gb = g * 32768;
    PH(7) {
      EpiUQ eq{ws, gb};
      EpiUKV ekv{ws, gb};
      for (int tile = vb; tile < 128 * 14; tile += gridDim.x) {
        const int tt = tile / 14, ct = tile % 14;
        if (ct < 6) gemm_tile((const bf16_t*)(ws + WS_LAT), 672, (const bf16_t*)(ws + WS_WTUQ), 384, gb + tt * 256, ct * 256, smem, eq);
        else gemm_tile((const bf16_t*)(ws + WS_LAT) + 384, 672, (const bf16_t*)(ws + WS_WTUKV), 256, gb + tt * 256, (ct - 6) * 256, smem, ekv);
      }
    }
    grid.sync();
    PH(8) for (int item = vb; item < 2048; item += gridDim.x) {
      int seqtb, S, head, qb;
      if (g == 0) { const int sq = item >> 8; head = (item >> 4) & 15; qb = item & 15; S = 4096; seqtb = sq * 4096; }
      else { const int sq = item >> 10; head = (item >> 6) & 15; qb = item & 63; S = 16384; seqtb = 32768 + sq * 16384; }
      attn_item<2>((const bf16_t*)(ws + WS_QC) + (size_t)(seqtb - gb + qb * 256) * 1536 + head * 96, 1536,
                   (const bf16_t*)(ws + WS_KN) + (size_t)(seqtb - gb) * 1024 + head * 64, 1024,
                   (const bf16_t*)(ws + WS_LAT) + (size_t)seqtb * 672 + 640,
                   (const bf16_t*)(ws + WS_VT) + (size_t)(seqtb - gb) * 1024 + (size_t)head * 64 * S, S, 0, S / 64,
                   (bf16_t*)(ws + WS_G1) + (size_t)(seqtb + qb * 256) * 1024 + head * 64, nullptr, 0, 0, smem);
    }
    grid.sync();
  }

  PH(9) {
    EpiOut epi{p.xp, p.xs, p.out, 1};
    for (int tile = vb; tile < 256 * 4; tile += gridDim.x)
      gemm_tile((const bf16_t*)(ws + WS_G1), 1024, (const bf16_t*)(ws + WS_WTO1), 1024, (tile >> 2) * 256, (tile & 3) * 256, smem, epi);
  }
  grid.sync();

  PH(10) { IDS() for (int t = gw; t < 32768; t += nw)
    rmsnorm_2rows_f32(p.out + (size_t)t * 1024, p.out + (size_t)(t + 32768) * 1024, p.norm_f, lane);
  }
}

extern "C" void kernel_launch(void* const* d_in, const int* in_sizes, int n_in,
                              void* d_out, int out_size, void* d_ws, size_t ws_size,
                              hipStream_t stream) {
  static int grid_blocks = 0;
  if (!grid_blocks) {
    int dev = 0, cus = 0, per_cu = 0;
    (void)hipGetDevice(&dev);
    (void)hipDeviceGetAttribute(&cus, hipDeviceAttributeMultiprocessorCount, dev);
    (void)hipOccupancyMaxActiveBlocksPerMultiprocessor(&per_cu, mega, 512, 0);
    per_cu = 1;
    grid_blocks = cus * per_cu;
  }
  if (ws_size < WS_NEED) { fprintf(stderr, "workspace too small: %zu\n", ws_size); return; }
  Params p{};
  p.xp = (const float*)d_in[0]; p.xs = (const float*)d_in[1];
  p.norm_e = (const float*)d_in[2]; p.w_in_e = (const float*)d_in[3]; p.rpb = (const float*)d_in[4];
  p.qn = (const float*)d_in[5]; p.kn = (const float*)d_in[6]; p.w_out_e = (const float*)d_in[7];
  p.norm_o = (const float*)d_in[8]; p.w_in_o = (const float*)d_in[9]; p.qlat_g = (const float*)d_in[10];
  p.kvlat_g = (const float*)d_in[11]; p.w_uq = (const float*)d_in[12]; p.w_ukv = (const float*)d_in[13];
  p.w_out_o = (const float*)d_in[14]; p.norm_f = (const float*)d_in[15];
  p.out = (float*)d_out; p.ws = (char*)d_ws;
  void* args[] = {&p};
  hipError_t e = hipLaunchCooperativeKernel((void*)mega, dim3(grid_blocks), dim3(512), args, 0, stream);
  if (e != hipSuccess) fprintf(stderr, "cooperative launch failed: %s (grid %d)\n", hipGetErrorString(e), grid_blocks);
}
```
